# Optimizing an MI355X kernel written in HIP

```python
import math
import jax, jax.numpy as jnp
from jax import lax
import numpy as np

D_MODEL = 1024
BATCH = 8
SEQ = 2048
DEPTH = 4

CHUNK = 64
N_MIXERS = 2
N_A = (DEPTH + 1) // 2
N_B = DEPTH // 2
NORM_EPS = 1e-6

MLA_HEADS = 8
QK_NOPE = 128
QK_ROPE = 64
QK_HEAD = QK_NOPE + QK_ROPE
V_HEAD = 128
Q_LORA = 384
KV_LORA = 256
ROPE_BASE = 10000.0
Q_BLOCK = 128

LRU_WIDTH = D_MODEL
LRU_HEADS = 8
LRU_BLOCK = LRU_WIDTH // LRU_HEADS
CONV_WIDTH = 4
LRU_C = 8.0

DENSE_FF = 2816
N_EXPERTS = 8
TOP_K = 2
EXPERT_FF = 3584

MAX_POS_OFFSET = 8192

kernel_name = "hybrid_mla_rglru_moe_stream_encoder"


def rms_norm(x, g):
    x32 = x.astype(jnp.float32)
    y = x32 * lax.rsqrt(jnp.mean(x32 * x32, axis=-1, keepdims=True) + NORM_EPS)
    return (y * g.astype(jnp.float32)).astype(x.dtype)


def rope_tables(positions):
    inv = 1.0 / (ROPE_BASE ** (jnp.arange(0, QK_ROPE, 2, dtype=jnp.float32) / QK_ROPE))
    ang = positions.astype(jnp.float32)[..., None] * inv
    return jnp.cos(ang), jnp.sin(ang)


def apply_rope(x, cos, sin):
    x32 = x.astype(jnp.float32)
    half = QK_ROPE // 2
    x1, x2 = x32[..., :half], x32[..., half:]
    c = cos[:, :, None, :]
    s = sin[:, :, None, :]
    return jnp.concatenate([x1 * c - x2 * s, x1 * s + x2 * c], axis=-1).astype(x.dtype)


def chunk_causal_attention(q, k, v):
    b, s, h, dq = q.shape
    nb = s // Q_BLOCK
    scale = 1.0 / math.sqrt(dq)
    q_blocks = q.reshape(b, nb, Q_BLOCK, h, dq).transpose(1, 0, 2, 3, 4)
    key_chunk = jnp.arange(s) // CHUNK

    def one_block(args):
        qb, blk = args
        q_chunk = (blk * Q_BLOCK + jnp.arange(Q_BLOCK)) // CHUNK
        mask = key_chunk[None, :] <= q_chunk[:, None]
        sc = jnp.einsum('bqhd,bkhd->bhqk', qb, k, preferred_element_type=jnp.float32) * scale
        sc = jnp.where(mask[None, None], sc, -jnp.inf)
        p = jax.nn.softmax(sc, axis=-1)
        return jnp.einsum('bhqk,bkhd->bqhd', p.astype(v.dtype), v)

    out = lax.map(one_block, (q_blocks, jnp.arange(nb)))
    return out.transpose(1, 0, 2, 3, 4).reshape(b, s, h, v.shape[-1])


def mla_mixer(x, cos, sin, w_in, g_qa, w_qb, g_kva, w_kvb, g_qn, g_kn, w_o):
    b, s, _ = x.shape
    hcat = x @ w_in
    cq = hcat[..., :Q_LORA]
    ckv = hcat[..., Q_LORA:Q_LORA + KV_LORA]
    k_rope = hcat[..., Q_LORA + KV_LORA:]
    q = (rms_norm(cq, g_qa) @ w_qb).reshape(b, s, MLA_HEADS, QK_HEAD)
    kv = (rms_norm(ckv, g_kva) @ w_kvb).reshape(b, s, MLA_HEADS, QK_NOPE + V_HEAD)
    k_nope, v = kv[..., :QK_NOPE], kv[..., QK_NOPE:]
    k = jnp.concatenate(
        [k_nope, jnp.broadcast_to(k_rope[:, :, None, :], (b, s, MLA_HEADS, QK_ROPE))], axis=-1)
    q = rms_norm(q, g_qn)
    k = rms_norm(k, g_kn)
    q = jnp.concatenate([q[..., :QK_NOPE], apply_rope(q[..., QK_NOPE:], cos, sin)], axis=-1)
    k = jnp.concatenate([k[..., :QK_NOPE], apply_rope(k[..., QK_NOPE:], cos, sin)], axis=-1)
    o = chunk_causal_attention(q, k, v)
    return o.reshape(b, s, MLA_HEADS * V_HEAD) @ w_o


def rglru_mixer(x, w_in, b_in, conv_w, conv_b, w_gate_a, b_gate_a, w_gate_i, b_gate_i,
                lam, w_out, b_out):
    b, s, _ = x.shape
    hcat = x @ w_in + b_in
    gate_branch = jax.nn.gelu(hcat[..., :LRU_WIDTH], approximate=True)
    xb = hcat[..., LRU_WIDTH:]
    xp = jnp.pad(xb, ((0, 0), (CONV_WIDTH - 1, 0), (0, 0)))
    xc = conv_b + xp[:, 0:s] * conv_w[0]
    for j in range(1, CONV_WIDTH):
        xc = xc + xp[:, j:j + s] * conv_w[j]
    xh = xc.reshape(b, s, LRU_HEADS, LRU_BLOCK)
    r = jax.nn.sigmoid(jnp.einsum('bshi,hij->bshj', xh, w_gate_a) + b_gate_a).reshape(b, s, LRU_WIDTH)
    i = jax.nn.sigmoid(jnp.einsum('bshi,hij->bshj', xh, w_gate_i) + b_gate_i).reshape(b, s, LRU_WIDTH)
    log_a = LRU_C * r.astype(jnp.float32) * jax.nn.log_sigmoid(lam.astype(jnp.float32))
    a = jnp.exp(log_a)
    mult = jnp.sqrt(-jnp.expm1(2.0 * log_a))
    u = mult * (i * xc).astype(jnp.float32)

    def step(h_prev, inp):
        a_t, u_t = inp
        h_new = a_t * h_prev + u_t
        return h_new, h_new

    h0 = jnp.zeros((b, LRU_WIDTH), jnp.float32)
    _, hs = lax.scan(step, h0, (a.transpose(1, 0, 2), u.transpose(1, 0, 2)))
    y = hs.transpose(1, 0, 2).astype(x.dtype)
    return (y * gate_branch) @ w_out + b_out


def dense_swiglu(x, w1, w3, w2):
    return (jax.nn.silu(x @ w1) * (x @ w3)) @ w2


def moe_swiglu(x, w_router, b_router, w1, w3, w2):
    b, s, d = x.shape
    t = x.reshape(b * s, d)
    logits = jnp.dot(t, w_router, preferred_element_type=jnp.float32) + b_router.astype(jnp.float32)
    top_val, top_idx = lax.top_k(logits, TOP_K)
    top_w = jax.nn.softmax(top_val, axis=-1)
    gates = jnp.sum(jax.nn.one_hot(top_idx, N_EXPERTS, dtype=jnp.float32) * top_w[..., None], axis=1)
    out = jnp.zeros_like(t)
    for e in range(N_EXPERTS):
        he = jax.nn.silu(t @ w1[e]) * (t @ w3[e])
        out = out + gates[:, e:e + 1].astype(t.dtype) * (he @ w2[e])
    return out.reshape(b, s, d)


def _normal(k, shape, fan_in):
    return jax.random.normal(k, shape, jnp.float32) * (float(fan_in) ** -0.5)


def _gain(k, shape):
    return 1.0 + 0.02 * jax.random.normal(k, shape, jnp.float32)


def _bias(k, shape, scale=0.02):
    return scale * jax.random.normal(k, shape, jnp.float32)


def setup_inputs(seed: int = 0) -> dict:
    key = jax.random.key(seed)
    ks = jax.random.split(key, 40)
    d = D_MODEL
    x = jax.random.normal(ks[0], (BATCH, SEQ, d), jnp.float32)
    offset = jax.random.randint(ks[1], (BATCH, 1), 0, MAX_POS_OFFSET)
    positions = (jnp.arange(SEQ, dtype=jnp.int32)[None, :] + offset).astype(jnp.int32)

    norm_mix = _gain(ks[2], (DEPTH, d))
    norm_ffn = _gain(ks[3], (DEPTH, d))

    mla_w_in = _normal(ks[4], (N_A, d, Q_LORA + KV_LORA + QK_ROPE), d)
    mla_g_qa = _gain(ks[5], (N_A, Q_LORA))
    mla_w_qb = _normal(ks[6], (N_A, Q_LORA, MLA_HEADS * QK_HEAD), Q_LORA)
    mla_g_kva = _gain(ks[7], (N_A, KV_LORA))
    mla_w_kvb = _normal(ks[8], (N_A, KV_LORA, MLA_HEADS * (QK_NOPE + V_HEAD)), KV_LORA)
    mla_g_qn = _gain(ks[9], (N_A, QK_HEAD))
    mla_g_kn = _gain(ks[10], (N_A, QK_HEAD))
    mla_w_o = _normal(ks[11], (N_A, MLA_HEADS * V_HEAD, d), MLA_HEADS * V_HEAD)

    lru_w_in = _normal(ks[12], (N_B, d, 2 * LRU_WIDTH), d)
    lru_b_in = _bias(ks[13], (N_B, 2 * LRU_WIDTH))
    lru_conv_w = _normal(ks[14], (N_B, CONV_WIDTH, LRU_WIDTH), CONV_WIDTH)
    lru_conv_b = _bias(ks[15], (N_B, LRU_WIDTH))
    lru_w_gate_a = _normal(ks[16], (N_B, LRU_HEADS, LRU_BLOCK, LRU_BLOCK), LRU_BLOCK)
    lru_b_gate_a = _bias(ks[17], (N_B, LRU_HEADS, LRU_BLOCK))
    lru_w_gate_i = _normal(ks[18], (N_B, LRU_HEADS, LRU_BLOCK, LRU_BLOCK), LRU_BLOCK)
    lru_b_gate_i = _bias(ks[19], (N_B, LRU_HEADS, LRU_BLOCK))
    u = jax.random.uniform(ks[20], (N_B, LRU_WIDTH), jnp.float32, minval=0.9, maxval=0.999)
    sig = u ** (1.0 / LRU_C)
    lru_lambda = jnp.log(sig) - jnp.log1p(-sig)
    lru_w_out = _normal(ks[21], (N_B, LRU_WIDTH, d), LRU_WIDTH)
    lru_b_out = _bias(ks[22], (N_B, d))

    ffn_w1 = _normal(ks[23], (N_A, d, DENSE_FF), d)
    ffn_w3 = _normal(ks[24], (N_A, d, DENSE_FF), d)
    ffn_w2 = _normal(ks[25], (N_A, DENSE_FF, d), DENSE_FF)

    moe_w_router = _normal(ks[26], (N_B, d, N_EXPERTS), d)
    moe_b_router = _bias(ks[27], (N_B, N_EXPERTS), 0.01)
    moe_w1 = _normal(ks[28], (N_B, N_EXPERTS, d, EXPERT_FF), d)
    moe_w3 = _normal(ks[29], (N_B, N_EXPERTS, d, EXPERT_FF), d)
    moe_w2 = _normal(ks[30], (N_B, N_EXPERTS, EXPERT_FF, d), EXPERT_FF)

    return {
        "x": x, "positions": positions, "norm_mix": norm_mix, "norm_ffn": norm_ffn,
        "mla_w_in": mla_w_in, "mla_g_qa": mla_g_qa, "mla_w_qb": mla_w_qb,
        "mla_g_kva": mla_g_kva, "mla_w_kvb": mla_w_kvb, "mla_g_qn": mla_g_qn,
        "mla_g_kn": mla_g_kn, "mla_w_o": mla_w_o,
        "lru_w_in": lru_w_in, "lru_b_in": lru_b_in, "lru_conv_w": lru_conv_w,
        "lru_conv_b": lru_conv_b, "lru_w_gate_a": lru_w_gate_a, "lru_b_gate_a": lru_b_gate_a,
        "lru_w_gate_i": lru_w_gate_i, "lru_b_gate_i": lru_b_gate_i, "lru_lambda": lru_lambda,
        "lru_w_out": lru_w_out, "lru_b_out": lru_b_out,
        "ffn_w1": ffn_w1, "ffn_w3": ffn_w3, "ffn_w2": ffn_w2,
        "moe_w_router": moe_w_router, "moe_b_router": moe_b_router,
        "moe_w1": moe_w1, "moe_w3": moe_w3, "moe_w2": moe_w2,
    }


def reference(x, positions, norm_mix, norm_ffn,
              mla_w_in, mla_g_qa, mla_w_qb, mla_g_kva, mla_w_kvb, mla_g_qn, mla_g_kn, mla_w_o,
              lru_w_in, lru_b_in, lru_conv_w, lru_conv_b, lru_w_gate_a, lru_b_gate_a,
              lru_w_gate_i, lru_b_gate_i, lru_lambda, lru_w_out, lru_b_out,
              ffn_w1, ffn_w3, ffn_w2,
              moe_w_router, moe_b_router, moe_w1, moe_w3, moe_w2):
    cos, sin = rope_tables(positions)
    for i in range(DEPTH):
        j = i // N_MIXERS
        xn = rms_norm(x, norm_mix[i])
        if i % N_MIXERS == 0:
            x = x + mla_mixer(xn, cos, sin, mla_w_in[j], mla_g_qa[j], mla_w_qb[j], mla_g_kva[j],
                              mla_w_kvb[j], mla_g_qn[j], mla_g_kn[j], mla_w_o[j])
        else:
            x = x + rglru_mixer(xn, lru_w_in[j], lru_b_in[j], lru_conv_w[j], lru_conv_b[j],
                                lru_w_gate_a[j], lru_b_gate_a[j], lru_w_gate_i[j], lru_b_gate_i[j],
                                lru_lambda[j], lru_w_out[j], lru_b_out[j])
        xn = rms_norm(x, norm_ffn[i])
        if i % 2 == 0:
            x = x + dense_swiglu(xn, ffn_w1[j], ffn_w3[j], ffn_w2[j])
        else:
            x = x + moe_swiglu(xn, moe_w_router[j], moe_b_router[j], moe_w1[j], moe_w3[j], moe_w2[j])
    return x
```

```cpp
#include <hip/hip_runtime.h>
#include <cstdio>
#include <cstdint>
#include <cstring>
constexpr size_t MiB = 1u << 20;
#define ONE_LAUNCH 1
#define FP8_ALL 1
#define FFN_F8 3
#define FFN_F8_LPS 2
constexpr int NWAVES = 8;
constexpr int TT = 16384, DM = 1024, SEQL = 2048;
constexpr float NEPS = 1e-6f;
#ifndef FP8_LAST
#define FP8_LAST 1
#endif
#ifndef FP8_ALL
#define FP8_ALL 0
#endif
constexpr int FP8_LP = (FP8_LAST && !FP8_ALL) ? 1 : -1;
#ifndef FFN_F8
#define FFN_F8 0
#endif
#ifndef FFN_F8_LPS
#define FFN_F8_LPS 2
#endif
__host__ __device__ constexpr bool ffn_fu8(int lp) { return (FFN_F8 & 1) != 0 && ((FFN_F8_LPS >> lp) & 1) != 0; }
__host__ __device__ constexpr bool ffn_fd8(int lp) { return (FFN_F8 & 2) != 0 && ((FFN_F8_LPS >> lp) & 1) != 0; }
constexpr size_t FA_XB8 = 448 * MiB;
__host__ __device__ constexpr bool moe_f8(int lp) { return FP8_ALL || lp == FP8_LP; }
constexpr size_t WS_CTL = 0, CTL_ZERO_BYTES = 3 * MiB;
constexpr size_t WS_WT = 8 * MiB;
constexpr size_t WS_FACT = 404 * MiB;
constexpr int CW_TMO = 0, CW_CODE = 1, CW_BAR = 4096;
constexpr int CW_MOE = 8192;
constexpr int CW_SSQ = 262144;
static_assert((size_t)CW_SSQ * 4 + (size_t)14 * TT * 8 <= CTL_ZERO_BYTES, "CTL");
constexpr size_t WT_PAIR = 198 * MiB;
constexpr int CKV_LD = 320;
constexpr int CQ_LD = 448;
constexpr int WG_LD = 192;
constexpr int MOE8_PITCH = 1152;
constexpr size_t WO_WINA = 0, WO_WQB = WO_WINA + 768 * 1024 * 2, WO_WKVB = WO_WQB + 1536 * CQ_LD * 2, WO_WO = WO_WKVB + 2048 * CKV_LD * 2, WO_W13 = WO_WO + 1024 * 1024 * 2, WO_W2 = WO_W13 + 5632 * 1024 * 2,
                 WO_LIN = WO_W2 + 1024 * 2816 * 2, WO_WG = WO_LIN + 2048 * 1024 * 2, WO_WOUT = WO_WG + 8 * 256 * WG_LD * 2, WO_M13 = WO_WOUT + 1024 * 1024 * 2, WO_M2 = WO_M13 + (size_t)8 * 7168 * 1024 * 2,
                 WO_END = WO_M2 + (size_t)8 * 1024 * 3584 * 2;
static_assert(WO_END <= WT_PAIR && WS_WT + 2 * WT_PAIR <= WS_FACT, "weights map");
constexpr size_t FA_XB = 0;
constexpr size_t FA_H = 32 * MiB;
constexpr size_t FA_AS = 32 * MiB, FA_MH = 100 * MiB, FA_Y = 338 * MiB, FA_SLOT = 436 * MiB;
constexpr size_t FA_CQ = 32 * MiB, FA_CKV = 216 * MiB  , FA_KR = 52 * MiB, FA_Q = 56 * MiB, FA_K = 104 * MiB, FA_V = 152 * MiB, FA_O = 184 * MiB;
constexpr size_t FA_G = 32 * MiB, FA_XBR = 64 * MiB, FA_XC = 96 * MiB, FA_LA = 128 * MiB, FA_U = 160 * MiB, FA_YG = 192 * MiB;
constexpr size_t FA_ROPE = 440 * MiB;
constexpr size_t FA_RB = 446 * MiB;
constexpr size_t FA_COEF = 444 * MiB;
constexpr int RING_OFF = 0, RING_BYTES = 131072, XCH_OFF = RING_BYTES, XCH_BYTES = 8192, LDSCTL_OFF = XCH_OFF + XCH_BYTES, MISC_OFF = LDSCTL_OFF + 320, STAT_OFF = LDSCTL_OFF + 1024  , LDS_BYTES = 153600;
static_assert(MISC_OFF + 128 <= STAT_OFF && STAT_OFF + 12288 <= LDS_BYTES, "LDS map");

#define GAS __attribute__((address_space(1)))
#define LAS __attribute__((address_space(3)))
typedef unsigned short bf16;
typedef unsigned v4u __attribute__((ext_vector_type(4)));
typedef unsigned v2u __attribute__((ext_vector_type(2)));
typedef float f32x4 __attribute__((ext_vector_type(4)));
typedef float f32x2 __attribute__((ext_vector_type(2)));
typedef short bf16x8 __attribute__((ext_vector_type(8)));
typedef GAS unsigned gu32;
#define RLX_AGENT __ATOMIC_RELAXED, __HIP_MEMORY_SCOPE_AGENT
#define LDS_WAIT() asm volatile("s_waitcnt lgkmcnt(0)" ::: "memory")
#define VM_WAIT() asm volatile("s_waitcnt vmcnt(0)" ::: "memory")
__device__ __forceinline__ unsigned f2bf(float f) { unsigned u = __builtin_bit_cast(unsigned, f); return (u + 0x7fffu + ((u >> 16) & 1u)) >> 16; }
__device__ __forceinline__ unsigned pk2(float lo, float hi) { unsigned r; asm volatile("v_cvt_pk_bf16_f32 %0, %1, %2" : "=v"(r) : "v"(lo), "v"(hi)); return r; }
typedef __bf16 bf16v2_t __attribute__((ext_vector_type(2)));
__device__ __forceinline__ unsigned pk2c(float lo, float hi) { const f32x2 v = {lo, hi}; return __builtin_bit_cast(unsigned, __builtin_convertvector(v, bf16v2_t)); }
__device__ __forceinline__ float bflo(unsigned w) { return __builtin_bit_cast(float, w << 16); }
__device__ __forceinline__ float bfhi(unsigned w) { return __builtin_bit_cast(float, w & 0xffff0000u); }
__device__ __forceinline__ float fast_rcp(float x) { return __builtin_amdgcn_rcpf(x); }
__device__ __forceinline__ float fast_exp(float x) { return __builtin_amdgcn_exp2f(x * 1.4426950408889634f); }
__device__ __forceinline__ float silu_f(float x) { return x * fast_rcp(1.f + fast_exp(-x)); }
__device__ __forceinline__ float sigm_f(float x) { return fast_rcp(1.f + fast_exp(-x)); }
__device__ __forceinline__ float rstd_of(float ssq, float invn) { return __builtin_amdgcn_rsqf(ssq * invn + NEPS); }
typedef unsigned long long fx64;
__device__ __forceinline__ fx64 fx_of(float s) { return (fx64)(s * 268435456.f); }
__device__ __forceinline__ float fx_to(fx64 v) { return (float)v * 3.7252902984619140625e-9f; }
__device__ __forceinline__ void fx_add(fx64* p, float s) { __hip_atomic_fetch_add(p, fx_of(s), __ATOMIC_RELAXED, __HIP_MEMORY_SCOPE_AGENT); }
__device__ __forceinline__ float xshfl(float v, int mask, int lane) { return __builtin_bit_cast(float, __builtin_amdgcn_ds_bpermute((lane ^ mask) << 2, __builtin_bit_cast(int, v))); }
__device__ __forceinline__ int ishfl(int v, int src_lane) { return __builtin_amdgcn_ds_bpermute(src_lane << 2, v); }
__device__ __forceinline__ float wave_sum(float v, int lane) {
#pragma unroll
    for (int o = 1; o < 64; o <<= 1) v += xshfl(v, o, lane);
    return v;
}
namespace pg8 {
#define PG8_LAS __attribute__((address_space(3)))
typedef unsigned short bf16_t;
typedef short bf16x8 __attribute__((ext_vector_type(8)));
typedef float f32x4 __attribute__((ext_vector_type(4)));
typedef unsigned u32x4 __attribute__((ext_vector_type(4)));
constexpr int STAT_TAB = 131072 + 8192 + 1024;
constexpr int BM = 256, BK = 64, HALF = 128, HTB = HALF * BK * 2  , STAGE_BYTES = 8 * HTB, NXCD = 8, WGM = 8;

__host__ __device__ __forceinline__ int lds_byte(int r, int c) { const int st = (r >> 4) * 2 + (c >> 5), rr = r & 15, cc = c & 31, ob = rr * 64 + cc * 2; return st * 1024 + (ob ^ (((ob >> 9) & 1) << 5)); }
__host__ __device__ __forceinline__ void stage_rc(int b, int& R, int& C) { const int st = b / 1024, sb = b % 1024, swz = sb ^ (((sb >> 9) & 1) << 5); R = (st >> 1) * 16 + swz / 64; C = (st & 1) * 32 + (swz % 64) / 2; }
__host__ __device__ __forceinline__ int perm32(int rho) { const int n = rho >> 4, i = rho & 15; return 8 * (i >> 2) + 4 * n + (i & 3); }

struct Unit { int pm, pn; long aoff, boff; };
struct Gemm { const bf16_t* A; const bf16_t* Bt; int lda, ldb, K; int sa, sb; };

struct StaticOrder {
    int nM, nN, nwg, G, c; long astep, bstep;
    __host__ __device__ void init(int M, int N, int G_, int c_, int lda, int ldb) { nM = M / BM; nN = N / BM; nwg = nM * nN; G = G_; c = c_; astep = (long)BM * lda * 2; bstep = (long)BM * ldb * 2; }
    __host__ __device__ bool next(int i, Unit& u) const {
        const int L = i * G + c; if (L >= nwg) return false;
        int wgid = (int)L; { const int q = nwg / NXCD, r = nwg % NXCD, xcd = wgid % NXCD, off = wgid / NXCD; wgid = (xcd < r ? xcd * (q + 1) : r * (q + 1) + (xcd - r) * q) + off; }
        const int nig = WGM * nN, gid = wgid / nig, fm = gid * WGM, gsz = (nM - fm) < WGM ? (nM - fm) : WGM;
        u.pm = fm + ((wgid % nig) % gsz); u.pn = (wgid % nig) / gsz; u.aoff = u.pm * astep; u.boff = u.pn * bstep; return true;
    }
    __device__ __forceinline__ void a_ready(const Unit&) const {}
    __device__ __forceinline__ void done(const Unit&) const {}
};

typedef int v8i_t __attribute__((ext_vector_type(8)));
typedef short bf16x16 __attribute__((ext_vector_type(16)));
typedef int v4i_t __attribute__((ext_vector_type(4)));
template <class Epi, class Sched, bool ALIGN_EPI = false, bool SP2 = false, int KIND = 0, int DBG = 0>
__device__ __forceinline__ void gemm_phase(PG8_LAS unsigned char* lds, const Gemm g, const Sched& S, const Epi& E, const int wave_s  ) {
    int tid_; asm volatile("v_mbcnt_lo_u32_b32 %0, -1, 0\n\tv_mbcnt_hi_u32_b32 %0, -1, %0" : "=v"(tid_)); tid_ += wave_s * 64;
    const int tid = tid_, wid = __builtin_amdgcn_readfirstlane(tid >> 6), lane = tid & 63, wr = wid >> 2, wc = wid & 3, fr = lane & 15, fq = lane >> 4;
    const int K = g.K, nt = K / BK;
    unsigned voffA[2], voffB[2];
#pragma unroll
    for (int i = 0; i < 2; ++i) { int R, C; stage_rc(tid * 16 + i * 8192, R, C); const int Rb = Epi::PERM ? ((R & ~31) + perm32(R & 31)) : R;
        voffA[i] = (unsigned)(R * g.lda + C) * 2u; voffB[i] = (unsigned)(Rb * g.ldb + C) * 2u; }
    const size_t kstep = (size_t)(BK * 2);
    const size_t hstepA = (size_t)HALF * g.lda * 2, hstepB = (size_t)HALF * g.ldb * 2;
    const unsigned ldsw = (unsigned)wid * 1024u;
    const int aoff = lds_byte(wr * 64 + fr, fq * 8), boff = lds_byte(wc * 32 + fr, fq * 8);
#define PG8_SA(b, h) (((b) * 2 + (h)) * HTB)
#define PG8_SB(b, h) ((4 + (b) * 2 + (h)) * HTB)
#define PG8_STAGE(bufoff, gbase, voff) do { if constexpr (!(DBG & 1)) { _Pragma("unroll") for (int _i = 0; _i < 2; ++_i) { unsigned vo_ = (voff)[_i]; asm volatile("" : "+v"(vo_)); \
        __builtin_amdgcn_global_load_lds((const unsigned*)((const char*)(gbase) + vo_), (PG8_LAS unsigned*)(lds + (bufoff) + ldsw + _i * 8192), 16, 0, 0); } } } while (0)
#define PG8_LDA(dst, b, h) do { if constexpr (!(DBG & 2)) { _Pragma("unroll") for (int m = 0; m < 4; ++m) { dst[m].lo = *(const PG8_LAS bf16x8*)(lds + PG8_SA(b, h) + aoff + m * 2048); dst[m].hi = *(const PG8_LAS bf16x8*)(lds + PG8_SA(b, h) + aoff + m * 2048 + 1024); if constexpr ((DBG & 4) != 0) asm volatile("" :: "v"(dst[m])); } } } while (0)
#define PG8_LDB(dst, b, h) do { if constexpr (!(DBG & 2)) { _Pragma("unroll") for (int n = 0; n < 2; ++n) { dst[n].lo = *(const PG8_LAS bf16x8*)(lds + PG8_SB(b, h) + boff + n * 2048); dst[n].hi = *(const PG8_LAS bf16x8*)(lds + PG8_SB(b, h) + boff + n * 2048 + 1024); if constexpr ((DBG & 4) != 0) asm volatile("" :: "v"(dst[n])); } } } while (0)
#define PG8_MMA(ai, bj, At, Bt) do { if constexpr (!(DBG & 4)) { __builtin_amdgcn_s_setprio(1); _Pragma("unroll") for (int m = 0; m < 4; ++m) _Pragma("unroll") for (int n = 0; n < 2; ++n) { \
        if constexpr (KIND == 0) { acc[ai][bj][m][n] = __builtin_amdgcn_mfma_f32_16x16x32_bf16(Bt[n].lo, At[m].lo, acc[ai][bj][m][n], 0, 0, 0); acc[ai][bj][m][n] = __builtin_amdgcn_mfma_f32_16x16x32_bf16(Bt[n].hi, At[m].hi, acc[ai][bj][m][n], 0, 0, 0); } \
        else acc[ai][bj][m][n] = __builtin_amdgcn_mfma_scale_f32_16x16x128_f8f6f4(__builtin_bit_cast(v8i_t, Bt[n]), __builtin_bit_cast(v8i_t, At[m]), acc[ai][bj][m][n], 0, 0, 0, 0, 0, 0); }   \
        __builtin_amdgcn_s_setprio(0); } } while (0)
#define PG8_WAIT_V(n) asm volatile("s_waitcnt vmcnt(" #n ")" ::: "memory")
#define PG8_WAIT_L(n) asm volatile("s_waitcnt lgkmcnt(" #n ")" ::: "memory")
#define PG8_BAR do { if constexpr (!(DBG & 8)) __builtin_amdgcn_s_barrier(); } while (0)
#define PG8_SCHED __builtin_amdgcn_sched_barrier(0)
    Unit cur, nxt; int ui = 0;
    if (!S.next(0, cur)) return;
    f32x4 acc[2][2][4][2];
#pragma unroll
    for (int a = 0; a < 2; ++a)
#pragma unroll
        for (int b = 0; b < 2; ++b)
#pragma unroll
            for (int m = 0; m < 4; ++m)
#pragma unroll
                for (int n = 0; n < 2; ++n) acc[a][b][m][n] = (f32x4){0.f, 0.f, 0.f, 0.f};
    bf16x16 At[4], B0[2], B1[2];
    const char* cA = (const char*)g.A + cur.aoff; const char* cB = (const char*)g.Bt + cur.boff;
    S.a_ready(cur);
#define PG8_STAT_FETCH(un, par) do { if constexpr (Epi::NSTAT > 0) { if (wid < 2 * Epi::NSTAT) { const char* sp_ = (const char*)E.tab_src(wid >> 1, un); const int nb_ = E.tab_bytes(wid >> 1) - (wid & 1) * 1024; \
        int l3_; asm volatile("v_mbcnt_lo_u32_b32 %0, -1, 0\n\tv_mbcnt_hi_u32_b32 %0, -1, %0" : "=v"(l3_));   \
        if (sp_ && l3_ * 16 < nb_) __builtin_amdgcn_global_load_lds((const unsigned*)(sp_ + (wid & 1) * 1024 + l3_ * 16), (PG8_LAS unsigned*)(lds + STAT_TAB + ((par) * Epi::NSTAT + (wid >> 1)) * 2048 + (wid & 1) * 1024), 16, 0, 0); } } } while (0)
    PG8_STAT_FETCH(cur, 0);
    if constexpr (SP2) {
        PG8_STAGE(PG8_SB(0, 0), cB, voffB); PG8_STAGE(PG8_SB(0, 1), cB + hstepB, voffB); PG8_STAGE(PG8_SA(0, 0), cA, voffA); PG8_STAGE(PG8_SA(0, 1), cA + hstepA, voffA);
        if (wr == 1) PG8_BAR;
        PG8_WAIT_V(2); PG8_BAR;
        PG8_STAGE(PG8_SB(1, 0), cB + kstep, voffB); PG8_STAGE(PG8_SA(1, 0), cA + kstep, voffA); PG8_STAGE(PG8_SB(1, 1), cB + hstepB + kstep, voffB);
        PG8_WAIT_V(6); PG8_BAR;
    } else {
        PG8_STAGE(PG8_SB(0, 0), cB, voffB); PG8_STAGE(PG8_SA(0, 0), cA, voffA); PG8_STAGE(PG8_SB(0, 1), cB + hstepB, voffB); PG8_STAGE(PG8_SA(0, 1), cA + hstepA, voffA);
        if (wr == 1) PG8_BAR;
        PG8_WAIT_V(4); PG8_BAR;
        PG8_STAGE(PG8_SB(1, 0), cB + kstep, voffB); PG8_STAGE(PG8_SA(1, 0), cA + kstep, voffA); PG8_STAGE(PG8_SB(1, 1), cB + hstepB + kstep, voffB);
        PG8_WAIT_V(6); PG8_BAR;
    }
    if constexpr ((DBG & 2) != 0) {
#pragma unroll
        for (int m = 0; m < 4; ++m) { At[m].lo = *(const PG8_LAS bf16x8*)(lds + aoff + m * 2048); At[m].hi = *(const PG8_LAS bf16x8*)(lds + aoff + m * 2048 + 1024); }
#pragma unroll
        for (int n = 0; n < 2; ++n) { B0[n].lo = *(const PG8_LAS bf16x8*)(lds + 4 * HTB + boff + n * 2048); B0[n].hi = *(const PG8_LAS bf16x8*)(lds + 4 * HTB + boff + n * 2048 + 1024); B1[n] = B0[n]; }
    }
    for (;;) {
        const bool has_next = S.next(ui + 1, nxt);
        const char* nA = has_next ? (const char*)g.A + nxt.aoff : cA; const char* nB = has_next ? (const char*)g.Bt + nxt.boff : cB;
        for (int t = 0; t < nt; t += 2) {
            const bool last = (t == nt - 2);
            const char* a1 = cA + (size_t)(t + 1) * kstep;
            const char* a2 = last ? nA : cA + (size_t)(t + 2) * kstep; const char* b2 = last ? nB : cB + (size_t)(t + 2) * kstep;
            const char* a3 = a2 + kstep; const char* b3 = b2 + kstep;
            if (last && has_next) { S.a_ready(nxt); PG8_STAT_FETCH(nxt, (ui + 1) & 1); }
            if constexpr (SP2) {
            PG8_LDB(B0, 0, 0); PG8_LDB(B1, 0, 1); PG8_SCHED; PG8_LDA(At, 0, 0); PG8_STAGE(PG8_SA(1, 1), a1 + hstepA, voffA);
            PG8_WAIT_V(8); PG8_WAIT_L(0); PG8_BAR; PG8_MMA(0, 0, At, B0); PG8_MMA(0, 1, At, B1); PG8_BAR; PG8_SCHED;
            PG8_LDA(At, 0, 1); PG8_STAGE(PG8_SB(0, 0), b2, voffB); PG8_STAGE(PG8_SB(0, 1), b2 + hstepB, voffB); PG8_STAGE(PG8_SA(0, 0), a2, voffA);
            PG8_WAIT_V(8); PG8_WAIT_L(0); PG8_BAR; PG8_MMA(1, 0, At, B0); PG8_MMA(1, 1, At, B1); PG8_BAR; PG8_SCHED;
            PG8_LDB(B0, 1, 0); PG8_LDB(B1, 1, 1); PG8_SCHED; PG8_LDA(At, 1, 0); PG8_STAGE(PG8_SA(0, 1), a2 + hstepA, voffA);
            PG8_WAIT_V(8); PG8_WAIT_L(0); PG8_BAR; PG8_MMA(0, 0, At, B0); PG8_MMA(0, 1, At, B1); PG8_BAR; PG8_SCHED;
            PG8_LDA(At, 1, 1); PG8_STAGE(PG8_SB(1, 0), b3, voffB); PG8_STAGE(PG8_SB(1, 1), b3 + hstepB, voffB); PG8_STAGE(PG8_SA(1, 0), a3, voffA);
            PG8_WAIT_V(8); PG8_WAIT_L(0); PG8_BAR; PG8_MMA(1, 0, At, B0); PG8_MMA(1, 1, At, B1); PG8_BAR; PG8_SCHED;
            } else {
            PG8_LDB(B0, 0, 0); PG8_SCHED; PG8_LDA(At, 0, 0); PG8_STAGE(PG8_SA(1, 1), a1 + hstepA, voffA);
            PG8_WAIT_L(8); PG8_BAR; PG8_WAIT_L(0); PG8_MMA(0, 0, At, B0); PG8_BAR; PG8_SCHED;
            PG8_LDB(B1, 0, 1); PG8_STAGE(PG8_SB(0, 0), b2, voffB);
            PG8_BAR; PG8_WAIT_L(0); PG8_MMA(0, 1, At, B1); PG8_BAR;
            PG8_LDA(At, 0, 1); PG8_STAGE(PG8_SA(0, 0), a2, voffA);
            PG8_BAR; PG8_WAIT_L(0); PG8_MMA(1, 0, At, B0); PG8_BAR; PG8_SCHED;
            PG8_STAGE(PG8_SB(0, 1), b2 + hstepB, voffB);
            PG8_WAIT_V(6); PG8_BAR; PG8_MMA(1, 1, At, B1); PG8_BAR;
            PG8_LDB(B0, 1, 0); PG8_SCHED; PG8_LDA(At, 1, 0); PG8_STAGE(PG8_SA(0, 1), a2 + hstepA, voffA);
            PG8_WAIT_L(8); PG8_BAR; PG8_WAIT_L(0); PG8_MMA(0, 0, At, B0); PG8_BAR; PG8_SCHED;
            PG8_LDB(B1, 1, 1); PG8_STAGE(PG8_SB(1, 0), b3, voffB);
            PG8_BAR; PG8_WAIT_L(0); PG8_MMA(0, 1, At, B1); PG8_BAR;
            PG8_LDA(At, 1, 1); PG8_STAGE(PG8_SA(1, 0), a3, voffA);
            PG8_BAR; PG8_WAIT_L(0); PG8_MMA(1, 0, At, B0); PG8_BAR; PG8_SCHED;
            PG8_STAGE(PG8_SB(1, 1), b3 + hstepB, voffB);
            PG8_WAIT_V(6); PG8_BAR; PG8_MMA(1, 1, At, B1); PG8_BAR;
            }
        }
        if constexpr (ALIGN_EPI) { if (wr == 0) PG8_BAR; }
        if constexpr (!Epi::AFTER_DRAIN) { int l2_; asm volatile("v_mbcnt_lo_u32_b32 %0, -1, 0\n\tv_mbcnt_hi_u32_b32 %0, -1, %0" : "=v"(l2_)); if constexpr (Epi::NSTAT > 0) E(acc, cur, wr, wc, l2_ & 15, l2_ >> 4, lds + STAT_TAB + (ui & 1) * Epi::NSTAT * 2048); else E(acc, cur, wr, wc, l2_ & 15, l2_ >> 4); S.done(cur); }
        if (!has_next) break;
#pragma unroll
        for (int a = 0; a < 2; ++a)
#pragma unroll
            for (int b = 0; b < 2; ++b)
#pragma unroll
                for (int m = 0; m < 4; ++m)
#pragma unroll
                    for (int n = 0; n < 2; ++n) acc[a][b][m][n] = (f32x4){0.f, 0.f, 0.f, 0.f};
        cur = nxt; cA = nA; cB = nB; ++ui;
        if constexpr (ALIGN_EPI) { if (wr == 1) PG8_BAR; }
    }
    PG8_WAIT_V(0);
    if constexpr (!ALIGN_EPI) { if (wr == 0) PG8_BAR; }
    PG8_BAR;
    if constexpr (Epi::AFTER_DRAIN) { E.fused(acc, cur, wr, wc, fr, fq, lds, wid, lane); S.done(cur); }
#undef PG8_STAT_FETCH
#undef PG8_SA
#undef PG8_SB
#undef PG8_STAGE
#undef PG8_LDA
#undef PG8_LDB
#undef PG8_MMA
#undef PG8_WAIT_V
#undef PG8_WAIT_L
#undef PG8_BAR
#undef PG8_SCHED
}
}
#define XB_LAS LAS
#define XB_TMO      128
#define XB_XCNT(j)  (256  + 64 * (j))
#define XB_XSUB(j)  (1280 + 64 * (j))
#define XB_XGEN(j)  (2304 + 64 * (j))
#define XB_TOP      3328
#define XB_TOPGEN   3392
#define XCD_BAR_WORDS 3456
#define XB_SPIN_CAP (1u << 18)

__device__ __forceinline__ unsigned xb_ld(unsigned* p)              { return __hip_atomic_load(p, __ATOMIC_RELAXED, __HIP_MEMORY_SCOPE_AGENT); }
__device__ __forceinline__ unsigned xb_add(unsigned* p, unsigned v) { return __hip_atomic_fetch_add(p, v, __ATOMIC_RELAXED, __HIP_MEMORY_SCOPE_AGENT); }
__device__ __forceinline__ unsigned xb_xcc_id() { return (unsigned)__builtin_amdgcn_s_getreg((3 << 11) | 20) & 0xFu; }
#define XB_SPIN(cond, bar) do { unsigned _sp = 0; while (cond) { __builtin_amdgcn_s_sleep(1); \
    if ((++_sp & 255u) == 0u) { if (xb_ld(&(bar)[XB_TMO])) break; if (_sp > XB_SPIN_CAP) { atomicAdd(&(bar)[XB_TMO], 1u); break; } } } } while (0)

struct XcdBarrier {
    unsigned* bar; unsigned x;
    volatile LAS unsigned* st;
};

__device__ __forceinline__ XcdBarrier xcd_barrier_post(unsigned* bar, volatile LAS unsigned* st, const bool t0  ) {
    XcdBarrier b; b.bar = bar; b.x = xb_xcc_id(); b.st = st;
    if (t0) (void)xb_add(&bar[XB_XCNT(b.x)], 1u);
    return b;
}
__device__ __forceinline__ void xcd_barrier_complete(unsigned* bar, unsigned x, unsigned& nloc, unsigned& nx) {
    const unsigned G = gridDim.x * gridDim.y * gridDim.z;
    unsigned sum, cnt, mine, sp = 0u;
    for (;;) {
        sum = 0u; cnt = 0u; mine = 0u;
#pragma unroll
        for (unsigned j = 0; j < 16; ++j) { const unsigned c = xb_ld(&bar[XB_XCNT(j)]); sum += c; cnt += (c > 0u) ? 1u : 0u; mine = (j == x) ? c : mine; }
        if (sum == G) break;
        __builtin_amdgcn_s_sleep(1);
        if ((++sp & 255u) == 0u) { if (xb_ld(&bar[XB_TMO])) break; if (sp > XB_SPIN_CAP) { atomicAdd(&bar[XB_TMO], 1u); break; } }
    }
    nloc = mine > 0u ? mine : 1u; nx = cnt > 0u ? cnt : 1u;
}

__device__ __forceinline__ void xcd_barrier(const XcdBarrier& b, const bool t0  ) {
    asm volatile("s_waitcnt vmcnt(0)" ::: "memory");
    __syncthreads();
    if (t0) {
        unsigned* bar = b.bar;
        __builtin_amdgcn_s_waitcnt(0);
        unsigned nloc = b.st[0], nx = b.st[1];
        if (nloc == 0u) { xcd_barrier_complete(bar, b.x, nloc, nx); b.st[0] = nloc; b.st[1] = nx; }
        const unsigned old = xb_add(&bar[XB_XSUB(b.x)], 1u);
        const unsigned gen = old / nloc;
        if (old + 1u == (gen + 1u) * nloc) {
            __builtin_amdgcn_fence(__ATOMIC_RELEASE, "agent");
            asm volatile("s_waitcnt vmcnt(0)" ::: "memory");
            const unsigned og = xb_add(&bar[XB_TOP], 1u);
            const unsigned tg = og / nx;
            if (og + 1u == (tg + 1u) * nx) xb_add(&bar[XB_TOPGEN], 1u);
            else XB_SPIN(xb_ld(&bar[XB_TOPGEN]) == tg, bar);
            __builtin_amdgcn_fence(__ATOMIC_ACQUIRE, "agent");
            xb_add(&bar[XB_XGEN(b.x)], 1u);
            asm volatile("s_waitcnt vmcnt(0)" ::: "memory");
        } else {
            XB_SPIN(xb_ld(&bar[XB_XGEN(b.x)]) == gen, bar);
            __builtin_amdgcn_fence(__ATOMIC_ACQUIRE, "agent");
            asm volatile("s_waitcnt vmcnt(0)" ::: "memory");
        }
    }
    __syncthreads();
}

struct Frame {
    LAS unsigned char* lds;
    volatile LAS unsigned* MISC;
    gu32* ctl;
    int tid, lane, wave, vcu, G;
    const float* const* in;
    float* X;
    unsigned char* ws;
};
#define FIN(k) (F.in[k])
__device__ __forceinline__ fx64* ssq_arr(const Frame& F, int inst) { return (fx64*)(F.ws + WS_CTL + (size_t)CW_SSQ * 4) + (size_t)inst * TT; }
__device__ __forceinline__ bf16* wt(const Frame& F, int lp, size_t off) { return (bf16*)(F.ws + WS_WT + (size_t)lp * WT_PAIR + off); }
__device__ __forceinline__ unsigned char* fact(const Frame& F, size_t off) { return F.ws + WS_FACT + off; }

struct CvtJob { const float* W0; long w1off; const float* g; bf16* dst; int K, Nd, ldw, mode, nvalid, ldd; float f8scale; };
__device__ __forceinline__ const float* cvt_src(const CvtJob& j, int n) {
    if (j.mode == 0) return n < j.nvalid ? j.W0 + n : nullptr;
    if (j.mode == 1) { const int tile = n >> 8, w = n & 255; return j.W0 + (w < 128 ? 0L : j.w1off) + tile * 128 + (w & 127); }
    if (j.mode == 3) return j.W0 + (n < 128 ? (long)n : j.w1off + (n - 128));
    if (n < 640) return j.W0 + n;
    if (n < 704) { const int r = n - 640, w = r >> 5, q = (r >> 3) & 3, nn = (r >> 2) & 1, jj = r & 3; return j.W0 + 640 + nn * 32 + 16 * w + 4 * q + jj; }
    return nullptr;
}
__device__ __forceinline__ void cvt_load(const CvtJob& j, int item, int lane, f32x4 (&v)[8]) {
    const int nblk = j.Nd / 32, kb = item / nblk, nb = item % nblk, k0 = 64 * kb, n0 = 32 * nb;
    const float* src = cvt_src(j, n0 + 4 * (lane & 7));
#pragma unroll
    for (int i = 0; i < 8; ++i) { const int kk = 8 * i + (lane >> 3); v[i] = src ? __builtin_nontemporal_load((const GAS f32x4*)(src + (size_t)(k0 + kk) * j.ldw)) : (f32x4){0.f, 0.f, 0.f, 0.f}; }
}
__device__ __forceinline__ void cvt_store(const CvtJob& j, LAS float* scr, int item, int lane, f32x4 (&v)[8]) {
    const int nblk = j.Nd / 32, kb = item / nblk, nb = item % nblk, k0 = 64 * kb, n0 = 32 * nb;
    if (j.g) {
#pragma unroll
        for (int i = 0; i < 8; ++i) v[i] = v[i] * j.g[k0 + 8 * i + (lane >> 3)]; }
#pragma unroll
    for (int i = 0; i < 8; ++i) *(LAS f32x4*)(scr + (8 * i + (lane >> 3)) * 36 + 4 * (lane & 7)) = v[i];
    LDS_WAIT(); asm volatile("" ::: "memory");
#pragma unroll
    for (int jj = 0; jj < 4; ++jj) { const int p = lane + 64 * jj, n = p >> 3, c = p & 7; const LAS float* s = scr + (8 * c) * 36 + n;
        if (j.f8scale != 0.f) { const float sc = j.f8scale; int lo = 0, hi = 0;
            lo = __builtin_amdgcn_cvt_pk_fp8_f32(s[0 * 36] * sc, s[1 * 36] * sc, lo, false); lo = __builtin_amdgcn_cvt_pk_fp8_f32(s[2 * 36] * sc, s[3 * 36] * sc, lo, true);
            hi = __builtin_amdgcn_cvt_pk_fp8_f32(s[4 * 36] * sc, s[5 * 36] * sc, hi, false); hi = __builtin_amdgcn_cvt_pk_fp8_f32(s[6 * 36] * sc, s[7 * 36] * sc, hi, true);
            *(GAS v2u*)((unsigned char*)j.dst + (size_t)(n0 + n) * j.ldd + k0 + 8 * c) = (v2u){(unsigned)lo, (unsigned)hi}; }
        else {
        v4u o; o.x = pk2(s[0 * 36], s[1 * 36]); o.y = pk2(s[2 * 36], s[3 * 36]); o.z = pk2(s[4 * 36], s[5 * 36]); o.w = pk2(s[6 * 36], s[7 * 36]);
        *(GAS v4u*)(j.dst + (size_t)(n0 + n) * j.ldd + k0 + 8 * c) = o; } }
    LDS_WAIT(); asm volatile("" ::: "memory");
}
constexpr int JOBS_PER_PAIR = 32;
__device__ __forceinline__ CvtJob make_job(const Frame& F, int idx) {
    const int lp = idx / JOBS_PER_PAIR, k = idx % JOBS_PER_PAIR; CvtJob j; j.w1off = 0; j.g = nullptr; j.mode = 0; j.f8scale = 0.f; j.ldd = 0;
    if (k == 0) { j.W0 = FIN(4) + (size_t)lp * 1024 * 704; j.g = FIN(2) + (2 * lp) * 1024; j.dst = wt(F, lp, WO_WINA); j.K = 1024; j.Nd = 768; j.ldw = 704; j.mode = 2; j.nvalid = 704; }
    else if (k == 1) { j.W0 = FIN(6) + (size_t)lp * 384 * 1536; j.g = FIN(5) + lp * 384; j.dst = wt(F, lp, WO_WQB); j.K = 384; j.Nd = 1536; j.ldw = 1536; j.nvalid = 1536; j.ldd = CQ_LD; }
    else if (k == 2) { j.W0 = FIN(8) + (size_t)lp * 256 * 2048; j.g = FIN(7) + lp * 256; j.dst = wt(F, lp, WO_WKVB); j.K = 256; j.Nd = 2048; j.ldw = 2048; j.nvalid = 2048; j.ldd = CKV_LD; }
    else if (k == 3) { j.W0 = FIN(11) + (size_t)lp * 1024 * 1024; j.dst = wt(F, lp, WO_WO); j.K = 1024; j.Nd = 1024; j.ldw = 1024; j.nvalid = 1024; }
    else if (k == 4) { j.W0 = FIN(23) + (size_t)lp * 1024 * 2816; j.w1off = (FIN(24) + (size_t)lp * 1024 * 2816) - j.W0; j.g = FIN(3) + (2 * lp) * 1024; j.dst = wt(F, lp, WO_W13); j.K = 1024; j.Nd = 5632; j.ldw = 2816; j.mode = 1; j.nvalid = 5632; if (ffn_fu8(lp)) j.f8scale = 64.f; }
    else if (k == 5) { j.W0 = FIN(25) + (size_t)lp * 2816 * 1024; j.dst = wt(F, lp, WO_W2); j.K = 2816; j.Nd = 1024; j.ldw = 1024; j.nvalid = 1024; if (ffn_fd8(lp)) j.f8scale = 64.f; }
    else if (k == 6) { j.W0 = FIN(12) + (size_t)lp * 1024 * 2048; j.g = FIN(2) + (2 * lp + 1) * 1024; j.dst = wt(F, lp, WO_LIN); j.K = 1024; j.Nd = 2048; j.ldw = 2048; j.nvalid = 2048; }
    else if (k < 15) { const int h = k - 7; j.W0 = FIN(16) + ((size_t)lp * 8 + h) * 128 * 128; j.w1off = (FIN(18) + ((size_t)lp * 8 + h) * 128 * 128) - j.W0; j.dst = wt(F, lp, WO_WG) + (size_t)h * 256 * WG_LD; j.K = 128; j.Nd = 256; j.ldw = 128; j.mode = 3; j.nvalid = 256; j.ldd = WG_LD; }
    else if (k == 15) { j.W0 = FIN(21) + (size_t)lp * 1024 * 1024; j.dst = wt(F, lp, WO_WOUT); j.K = 1024; j.Nd = 1024; j.ldw = 1024; j.nvalid = 1024; }
    else if (k < 24) { const int e = k - 16; j.W0 = FIN(28) + ((size_t)lp * 8 + e) * 1024 * 3584; j.w1off = (FIN(29) + ((size_t)lp * 8 + e) * 1024 * 3584) - j.W0; j.g = FIN(3) + (2 * lp + 1) * 1024; j.dst = wt(F, lp, WO_M13) + (size_t)e * 7168 * 1024; j.K = 1024; j.Nd = 7168; j.ldw = 3584; j.mode = 1; j.nvalid = 7168;
        if (moe_f8(lp)) { j.f8scale = 64.f; j.dst = (bf16*)((unsigned char*)wt(F, lp, WO_M13) + (size_t)e * 7168 * MOE8_PITCH); j.ldd = MOE8_PITCH; } }
    else { const int e = k - 24; j.W0 = FIN(30) + ((size_t)lp * 8 + e) * 3584 * 1024; j.dst = wt(F, lp, WO_M2) + (size_t)e * 1024 * 3584; j.K = 3584; j.Nd = 1024; j.ldw = 1024; j.nvalid = 1024;
        if (moe_f8(lp)) { j.f8scale = 128.f; j.dst = (bf16*)((unsigned char*)wt(F, lp, WO_M2) + (size_t)e * 1024 * 3584); } }
    if (j.ldd == 0) j.ldd = j.K;
    return j;
}
__device__ __forceinline__ void prep_rows(const Frame& F, const float* src, float* dstX, fx64* ssq) {
    const int gw = F.vcu * NWAVES + F.wave, NGW = F.G * NWAVES; bf16* XB = (bf16*)fact(F, FA_XB);
    for (int m = gw; m < TT; m += NGW) {
        const GAS f32x4* xr = (const GAS f32x4*)(src + (size_t)m * DM) + F.lane; f32x4 v[4]; float s = 0.f;
#pragma unroll
        for (int j = 0; j < 4; ++j) { v[j] = xr[64 * j]; s += (v[j].x * v[j].x + v[j].y * v[j].y) + (v[j].z * v[j].z + v[j].w * v[j].w); }
        s = wave_sum(s, F.lane); if (F.lane == 0) ssq[m] = fx_of(s);
        if (dstX) { GAS f32x4* xo = (GAS f32x4*)(dstX + (size_t)m * DM) + F.lane;
#pragma unroll
            for (int j = 0; j < 4; ++j) xo[64 * j] = v[j]; }
        GAS v2u* o8 = (GAS v2u*)(XB + (size_t)m * DM) + F.lane;
#pragma unroll
        for (int j = 0; j < 4; ++j) { v2u w; w.x = pk2(v[j].x, v[j].y); w.y = pk2(v[j].z, v[j].w); o8[64 * j] = w; }
    }
}
__device__ __forceinline__ void cvt_jobs(const Frame& F, int job_lo, int job_hi, const int gw, const int NGW) {
    LAS float* scr = (LAS float*)(F.lds + RING_OFF + F.wave * 16384);
    if (gw < 0) return;
    long base = 0;
    for (int ji = job_lo; ji < job_hi; ++ji) {
        const CvtJob j = make_job(F, ji); const int nitems = (j.K / 64) * (j.Nd / 32);
        int it0 = (int)((gw - base) % NGW); if (it0 < 0) it0 += NGW;
        if (it0 < nitems) { f32x4 va[8], vb[8]; cvt_load(j, it0, F.lane, va);
            for (int it = it0; it < nitems; it += 2 * NGW) {
                const bool hb = it + NGW < nitems, ha = it + 2 * NGW < nitems;
                if (hb) cvt_load(j, it + NGW, F.lane, vb);
                cvt_store(j, scr, it, F.lane, va);
                if (ha) cvt_load(j, it + 2 * NGW, F.lane, va);
                if (hb) cvt_store(j, scr, it + NGW, F.lane, vb);
            } }
        base += nitems;
    }
}
#ifndef TAIL_SLOTS
#define TAIL_SLOTS 1
#endif
__device__ __forceinline__ void tail_convert(const Frame& P, int job_lo, int job_hi, int first_idle) {
    const int c = (int)blockIdx.x; int l_; asm volatile("v_mbcnt_lo_u32_b32 %0, -1, 0\n\tv_mbcnt_hi_u32_b32 %0, -1, %0" : "=v"(l_));
    if (first_idle >= P.G) first_idle = 0;
    Frame Q_ = P; Q_.lane = l_; cvt_jobs(Q_, job_lo, job_hi, c >= first_idle ? (c - first_idle) * NWAVES + P.wave : -1, (P.G - first_idle) * NWAVES);
}
__device__ __forceinline__ void p0_prologue(const Frame& F, int job_lo, int job_hi, const bool rest = true) {
    LAS float* scr = (LAS float*)(F.lds + RING_OFF + F.wave * 16384);
    const int gw = F.vcu * NWAVES + F.wave, NGW = F.G * NWAVES;
    if (TAIL_SLOTS && job_lo == 0 && job_hi == 2 * JOBS_PER_PAIR) { cvt_jobs(F, 0, 48, gw, NGW); cvt_jobs(F, 55, 56, gw, NGW); job_lo = 59; job_hi = 64; }
    long base = 0;
    for (int ji = job_lo; ji < job_hi; ++ji) {
        const CvtJob j = make_job(F, ji); const int nitems = (j.K / 64) * (j.Nd / 32);
        int it0 = (int)((gw - base) % NGW); if (it0 < 0) it0 += NGW;
        if (it0 < nitems) { f32x4 va[8], vb[8]; cvt_load(j, it0, F.lane, va);
            for (int it = it0; it < nitems; it += 2 * NGW) {
                const bool hb = it + NGW < nitems, ha = it + 2 * NGW < nitems;
                if (hb) cvt_load(j, it + NGW, F.lane, vb);
                cvt_store(j, scr, it, F.lane, va);
                if (ha) cvt_load(j, it + 2 * NGW, F.lane, va);
                if (hb) cvt_store(j, scr, it + NGW, F.lane, vb);
            } }
        base += nitems;
    }
    if (!rest) return;
    { float* cs = (float*)fact(F, FA_ROPE); const int* pos = (const int*)F.in[1];
      for (int i = (F.vcu * NWAVES + F.wave) * 64 + F.lane; i < TT * 32; i += NGW * 64) { const int t = i >> 5, fi = i & 31;
          const float inv = 1.0f / powf(10000.0f, (float)(2 * fi) / 64.0f); const float ang = (float)pos[t] * inv; cs[i] = cosf(ang); cs[TT * 32 + i] = sinf(ang); } }
    { float* coef = (float*)fact(F, FA_COEF); const float* lam = F.in[20];
      for (int i = (F.vcu * NWAVES + F.wave) * 64 + F.lane; i < 2048; i += NGW * 64) { const float L = lam[i]; const float ls = (L >= 0.f) ? -log1pf(expf(-L)) : (L - log1pf(expf(L))); coef[i] = 8.f * ls * 1.4426950408889634f; } }
    { unsigned char* rb = fact(F, FA_RB);
      for (int i = (F.vcu * NWAVES + F.wave) * 64 + F.lane; i < 2 * 32 * 64; i += NGW * 64) { const int l2 = i >> 11, r = i & 2047, ks = r >> 6, ln = r & 63, fq = ln >> 4, fr = ln & 15, e = fr & 7;
          const float* wr = F.in[26] + l2 * 8192; const float* g = F.in[3] + (2 * l2 + 1) * 1024; unsigned w[4];
#pragma unroll
          for (int p2 = 0; p2 < 4; ++p2) { unsigned h[2];
#pragma unroll
              for (int q = 0; q < 2; ++q) { const int k = 32 * ks + 8 * fq + 2 * p2 + q; const float wf = g[k] * wr[k * 8 + e]; const unsigned hi = f2bf(wf); h[q] = fr < 8 ? hi : f2bf(wf - __builtin_bit_cast(float, hi << 16)); }
              w[p2] = h[0] | (h[1] << 16); }
          *(v4u*)(rb + (size_t)i * 16) = (v4u){w[0], w[1], w[2], w[3]}; } }
    prep_rows(F, F.in[0], F.X, ssq_arr(F, 0));
}

namespace pg8 {
struct EpiSwiGLU {
    static constexpr bool PERM = true, AFTER_DRAIN = false; static constexpr int NSTAT = 1;
    bf16_t* H; int ldh; const fx64* ssq; int tpg; int f8out; float accscale;
    __device__ __forceinline__ const void* tab_src(int, const Unit& u) const { return ssq ? ssq + (size_t)u.pm * BM : nullptr; }
    __device__ __forceinline__ int tab_bytes(int) const { return 2048; }
    __device__ __forceinline__ void operator()(const f32x4 (&acc)[2][2][4][2], const Unit& u, int wr, int wc, int fr, int fq, const PG8_LAS unsigned char* tab) const {
        const int row0 = u.pm * BM + wr * 64 + fr, col0 = (u.pn % tpg) * 128 + wc * 32 + 8 * fq;
        float rsv[2][4];
#pragma unroll
        for (int ai = 0; ai < 2; ++ai)
#pragma unroll
            for (int m = 0; m < 4; ++m) rsv[ai][m] = ssq ? fx_to(*(const PG8_LAS unsigned long long*)(tab + (wr * 64 + fr + ai * HALF + m * 16) * 8)) : 0.f;
        const float ias2 = 1.f / (accscale * accscale);
#pragma unroll
        for (int ai = 0; ai < 2; ++ai)
#pragma unroll
            for (int m = 0; m < 4; ++m) { const int row = row0 + ai * HALF + m * 16;
                float c1, is2;
                if (ssq) { const float v = rsv[ai][m] * (1.f / 1024.f) + NEPS; c1 = __builtin_amdgcn_rsqf(v) * accscale * -1.4426950408889634f; is2 = v * ias2; }
                else { c1 = accscale * -1.4426950408889634f; is2 = ias2; }
                const float c0 = __builtin_amdgcn_logf(is2);
                float t[8], p[8], h[8];
#pragma unroll
                for (int n = 0; n < 2; ++n)
#pragma unroll
                    for (int j = 0; j < 4; ++j) { const float a = acc[ai][0][m][n][j]; t[4 * n + j] = __builtin_fmaf(a, c1, c0); p[4 * n + j] = a * acc[ai][1][m][n][j]; }
                __builtin_amdgcn_sched_barrier(0);
#pragma unroll
                for (int k = 0; k < 8; ++k) t[k] = __builtin_amdgcn_exp2f(t[k]);
                __builtin_amdgcn_sched_barrier(0);
#pragma unroll
                for (int k = 0; k < 8; ++k) t[k] = t[k] + is2;
                __builtin_amdgcn_sched_barrier(0);
#pragma unroll
                for (int k = 0; k < 8; ++k) t[k] = __builtin_amdgcn_rcpf(t[k]);
                __builtin_amdgcn_sched_barrier(0);
#pragma unroll
                for (int k = 0; k < 8; ++k) h[k] = p[k] * t[k];
                if (f8out) { int lo = 0, hi = 0; lo = __builtin_amdgcn_cvt_pk_fp8_f32(h[0], h[1], lo, false); lo = __builtin_amdgcn_cvt_pk_fp8_f32(h[2], h[3], lo, true);
                    hi = __builtin_amdgcn_cvt_pk_fp8_f32(h[4], h[5], hi, false); hi = __builtin_amdgcn_cvt_pk_fp8_f32(h[6], h[7], hi, true);
                    *(v2u*)((unsigned char*)H + (size_t)row * ldh + col0) = (v2u){(unsigned)lo, (unsigned)hi}; }
                else { u32x4 w; w.x = pk2(h[0], h[1]); w.y = pk2(h[2], h[3]); w.z = pk2(h[4], h[5]); w.w = pk2(h[6], h[7]);
                *(u32x4*)(H + (size_t)row * ldh + col0) = w; } }
    }
};
struct EpiResid {
    static constexpr bool PERM = true, AFTER_DRAIN = false; static constexpr int NSTAT = 0;
    float* X; bf16_t* XB; fx64* ssq_out; const float* bias;
#if FFN_F8
    unsigned char* XB8; float accscale;
#else
    static constexpr unsigned char* XB8 = nullptr; static constexpr float accscale = 1.f;
#endif
    __device__ __forceinline__ void operator()(const f32x4 (&acc)[2][2][4][2], const Unit& u, int wr, int wc, int fr, int fq) const {
        const int row0 = u.pm * BM + wr * 64 + fr, col0 = u.pn * BM + wc * 32 + 8 * fq;
        f32x4 bv[2][2];
#pragma unroll
        for (int bj = 0; bj < 2; ++bj)
#pragma unroll
            for (int n = 0; n < 2; ++n) bv[bj][n] = bias ? *(const f32x4*)(bias + col0 + bj * HALF + 4 * n) : (f32x4){0.f, 0.f, 0.f, 0.f};
#pragma unroll
        for (int ai = 0; ai < 2; ++ai) {
            f32x4 xr[4][2][2];
#pragma unroll
            for (int m = 0; m < 4; ++m)
#pragma unroll
                for (int bj = 0; bj < 2; ++bj) { const float* xp = X + (size_t)(row0 + ai * HALF + m * 16) * DM + col0 + bj * HALF; xr[m][bj][0] = *(const f32x4*)xp; xr[m][bj][1] = *(const f32x4*)(xp + 4); }
#pragma unroll
            for (int m = 0; m < 4; ++m) { const int row = row0 + ai * HALF + m * 16; float s = 0.f;
#pragma unroll
                for (int bj = 0; bj < 2; ++bj) { float* xp = X + (size_t)row * DM + col0 + bj * HALF;
                    f32x4 v0 = xr[m][bj][0] + acc[ai][bj][m][0] * accscale + bv[bj][0], v1 = xr[m][bj][1] + acc[ai][bj][m][1] * accscale + bv[bj][1];
                    *(f32x4*)xp = v0; *(f32x4*)(xp + 4) = v1;
                    s += (v0[0] * v0[0] + v0[1] * v0[1]) + (v0[2] * v0[2] + v0[3] * v0[3]) + (v1[0] * v1[0] + v1[1] * v1[1]) + (v1[2] * v1[2] + v1[3] * v1[3]);
                    u32x4 w; w.x = pk2(v0[0], v0[1]); w.y = pk2(v0[2], v0[3]); w.z = pk2(v1[0], v1[1]); w.w = pk2(v1[2], v1[3]);
                    *(u32x4*)(XB + (size_t)row * DM + col0 + bj * HALF) = w;
                    if (XB8) { int lo = 0, hi = 0; lo = __builtin_amdgcn_cvt_pk_fp8_f32(v0[0], v0[1], lo, false); lo = __builtin_amdgcn_cvt_pk_fp8_f32(v0[2], v0[3], lo, true);
                        hi = __builtin_amdgcn_cvt_pk_fp8_f32(v1[0], v1[1], hi, false); hi = __builtin_amdgcn_cvt_pk_fp8_f32(v1[2], v1[3], hi, true);
                        *(v2u*)(XB8 + (size_t)row * DM + col0 + bj * HALF) = (v2u){(unsigned)lo, (unsigned)hi}; } }
                { const int ln_ = fq * 16 + fr; s += xshfl(s, 16, ln_); s += xshfl(s, 32, ln_); }
                if (ssq_out && fq == 0) fx_add(ssq_out + row, s); } }
    }
};
}
constexpr int MAXSLOT = 136 * 256;
constexpr size_t SL_TOKSLOT = 0, SL_GATE = 256 * 1024, SL_SSQ = 512 * 1024  , SL_RE = 1024 * 1024, SL_RW = 1280 * 1024, SL_RSSQ = 1536 * 1024;

__device__ __forceinline__ void r1_phase(const Frame& F, int lp) {
    const float* br = FIN(27) + lp * 8;
    int* r_e = (int*)fact(F, FA_SLOT + SL_RE); float* r_w = (float*)fact(F, FA_SLOT + SL_RW); float* r_ssq = (float*)fact(F, FA_SLOT + SL_RSSQ);
    LAS unsigned* cnt = (LAS unsigned*)(F.lds + XCH_OFF);
    LAS unsigned char* bimg = F.lds + RING_OFF; LAS float* xpart = (LAS float*)(F.lds + RING_OFF + 32768);
    if (F.tid < 8) cnt[F.tid] = 0u;
    { const unsigned char* rb = fact(F, FA_RB) + (size_t)lp * 32768;
#pragma unroll
      for (int j = 0; j < 4; ++j) __builtin_amdgcn_global_load_lds((const unsigned*)(rb + (F.wave * 4 + j) * 1024 + F.lane * 16), (LAS unsigned*)(bimg + (F.wave * 4 + j) * 1024), 16, 0, 0); }
    float bre[8];
#pragma unroll
    for (int e = 0; e < 8; ++e) bre[e] = br[e];
    const int gic = F.wave >> 1, kh = F.wave & 1, fr = F.lane & 15, fq = F.lane >> 4;
    for (int it = 0; it * F.G * 4 < TT / 16; ++it) {
        const int gi = (it * F.G + F.vcu) * 4 + gic; const bool valid = gi < TT / 16;
        f32x4 xa[16][2];
        if (valid) { const GAS f32x4* xp = (const GAS f32x4*)(F.X + (size_t)(gi * 16 + fr) * DM + kh * 512 + 8 * fq);
#pragma unroll
            for (int ks = 0; ks < 16; ++ks) { xa[ks][0] = xp[8 * ks]; xa[ks][1] = xp[8 * ks + 1]; } }
        VM_WAIT(); __syncthreads();
        f32x4 acc = {0.f, 0.f, 0.f, 0.f}; float s = 0.f;
        if (valid) {
#pragma unroll
            for (int ks = 0; ks < 16; ++ks) { const pg8::bf16x8 bfrag = *(const LAS pg8::bf16x8*)(bimg + (kh * 16 + ks) * 1024 + F.lane * 16);
                const f32x4 a = xa[ks][0], b = xa[ks][1];
                s += ((a.x * a.x + a.y * a.y) + (a.z * a.z + a.w * a.w)) + ((b.x * b.x + b.y * b.y) + (b.z * b.z + b.w * b.w));
                const v4u hi = {pk2c(a.x, a.y), pk2c(a.z, a.w), pk2c(b.x, b.y), pk2c(b.z, b.w)};
                const v4u lo = {pk2c(a.x - bflo(hi.x), a.y - bfhi(hi.x)), pk2c(a.z - bflo(hi.y), a.w - bfhi(hi.y)), pk2c(b.x - bflo(hi.z), b.y - bfhi(hi.z)), pk2c(b.z - bflo(hi.w), b.w - bfhi(hi.w))};
                acc = __builtin_amdgcn_mfma_f32_16x16x32_bf16(bfrag, __builtin_bit_cast(pg8::bf16x8, hi), acc, 0, 0, 0);
                acc = __builtin_amdgcn_mfma_f32_16x16x32_bf16(bfrag, __builtin_bit_cast(pg8::bf16x8, lo), acc, 0, 0, 0); }
            s += xshfl(s, 16, F.lane); s += xshfl(s, 32, F.lane);
            if (kh == 1) { LAS float* d = xpart + (gic * 64 + F.lane) * 5; d[0] = acc[0]; d[1] = acc[1]; d[2] = acc[2]; d[3] = acc[3]; d[4] = s; }
        }
        __syncthreads();
        if (valid && kh == 0) { const LAS float* d = xpart + (gic * 64 + F.lane) * 5; acc[0] += d[0]; acc[1] += d[1]; acc[2] += d[2]; acc[3] += d[3]; s += d[4];
            float lg[8];
#pragma unroll
            for (int r = 0; r < 4; ++r) lg[r] = acc[r] + xshfl(acc[r], 32, F.lane);
#pragma unroll
            for (int r = 0; r < 4; ++r) lg[4 + r] = xshfl(lg[r], 16, F.lane);
            if (fq == 0) { const float rs = 1.0f / sqrtf(s * (1.f / 1024.f) + NEPS);
#pragma unroll
                for (int e = 0; e < 8; ++e) lg[e] = lg[e] * rs + bre[e];
                int e1 = 0; float v1 = lg[0];
#pragma unroll
                for (int e = 1; e < 8; ++e) if (lg[e] > v1) { v1 = lg[e]; e1 = e; }
                int e2 = -1; float v2 = -3.0e38f;
#pragma unroll
                for (int e = 0; e < 8; ++e) if (e != e1 && lg[e] > v2) { v2 = lg[e]; e2 = e; }
                const int m = gi * 16 + fr; const float p2 = expf(v2 - v1), inv = 1.f / (1.f + p2); r_e[m] = e1 | (e2 << 8); r_w[2 * m] = inv; r_w[2 * m + 1] = p2 * inv; r_ssq[m] = s;
                __hip_atomic_fetch_add(cnt + e1, 1u, __ATOMIC_RELAXED, __HIP_MEMORY_SCOPE_WORKGROUP); __hip_atomic_fetch_add(cnt + e2, 1u, __ATOMIC_RELAXED, __HIP_MEMORY_SCOPE_WORKGROUP); } }
        __syncthreads();
    }
    if (F.tid < 8) __hip_atomic_fetch_add(F.ctl + CW_MOE + 64 * lp + F.tid, cnt[F.tid], RLX_AGENT);
}

struct MoeSeg { int np[8], ps[8], total; };
__device__ __forceinline__ MoeSeg moe_segments(const Frame& F, int lp) {
    MoeSeg s; int acc = 0;
#pragma unroll
    for (int e = 0; e < 8; ++e) { const int c = (int)__builtin_amdgcn_readfirstlane(__hip_atomic_load(F.ctl + CW_MOE + 64 * lp + e, RLX_AGENT)); s.np[e] = (c + 255) >> 8; s.ps[e] = acc; acc += s.np[e]; }
    s.total = acc; return s;
}

__device__ __forceinline__ void r2_phase(const Frame& F, int lp) {
    const MoeSeg sg = moe_segments(F, lp);
    const int* r_e = (const int*)fact(F, FA_SLOT + SL_RE); const float* r_w = (const float*)fact(F, FA_SLOT + SL_RW); const float* r_ssq = (const float*)fact(F, FA_SLOT + SL_RSSQ);
    int* tok_slot = (int*)fact(F, FA_SLOT + SL_TOKSLOT); float* slot_gate = (float*)fact(F, FA_SLOT + SL_GATE); fx64* slot_ssq = (fx64*)fact(F, FA_SLOT + SL_SSQ);
    const bf16* XB = (const bf16*)fact(F, FA_XB); bf16* AS = (bf16*)fact(F, FA_AS);
    LAS int* slots = (LAS int*)(F.lds + XCH_OFF + 64);
    for (int grp = blockIdx.x; grp < TT / 64; grp += F.G) {
        if (F.wave == 0) {
            const int t = grp * 64 + F.lane; const int re = r_e[t]; const int ek[2] = {re & 255, re >> 8};
            unsigned long long mk[2][8]; int my_n = 0;
#pragma unroll
            for (int k = 0; k < 2; ++k)
#pragma unroll
                for (int e = 0; e < 8; ++e) { mk[k][e] = __ballot(ek[k] == e); if (F.lane == 8 * k + e) my_n = __popcll(mk[k][e]); }
            unsigned base = 0u;
            if (F.lane < 16 && my_n > 0) base = __hip_atomic_fetch_add(F.ctl + CW_MOE + 64 * lp + 16 + (F.lane & 7), (unsigned)my_n, RLX_AGENT);
#pragma unroll
            for (int k = 0; k < 2; ++k) { const int e = ek[k]; unsigned long long mm = mk[k][0]; int pse = sg.ps[0];
#pragma unroll
                for (int q = 1; q < 8; ++q) { if (e == q) { mm = mk[k][q]; pse = sg.ps[q]; } }
                const int slot = pse * 256 + ishfl((int)base, 8 * k + e) + __popcll(mm & ((1ull << F.lane) - 1ull));
                slots[k * 64 + F.lane] = slot; tok_slot[2 * t + k] = slot; slot_gate[slot] = r_w[2 * t + k]; slot_ssq[slot] = fx_of(r_ssq[t]); }
        }
        __syncthreads();
#pragma unroll
        for (int i = 0; i < 8; ++i) { const int tl = 8 * F.wave + i, t = grp * 64 + tl; const int s1 = slots[tl], s2 = slots[64 + tl];
            if (moe_f8(lp)) {
                const GAS v4u* src = (const GAS v4u*)(XB + (size_t)t * DM) + 2 * F.lane; const v4u a = src[0], b = src[1]; int w0 = 0, w1 = 0, w2 = 0, w3 = 0; const float rn = rstd_of(r_ssq[t], 1.f / 1024.f);
                w0 = __builtin_amdgcn_cvt_pk_fp8_f32(bflo(a.x) * rn, bfhi(a.x) * rn, w0, false); w0 = __builtin_amdgcn_cvt_pk_fp8_f32(bflo(a.y) * rn, bfhi(a.y) * rn, w0, true);
                w1 = __builtin_amdgcn_cvt_pk_fp8_f32(bflo(a.z) * rn, bfhi(a.z) * rn, w1, false); w1 = __builtin_amdgcn_cvt_pk_fp8_f32(bflo(a.w) * rn, bfhi(a.w) * rn, w1, true);
                w2 = __builtin_amdgcn_cvt_pk_fp8_f32(bflo(b.x) * rn, bfhi(b.x) * rn, w2, false); w2 = __builtin_amdgcn_cvt_pk_fp8_f32(bflo(b.y) * rn, bfhi(b.y) * rn, w2, true);
                w3 = __builtin_amdgcn_cvt_pk_fp8_f32(bflo(b.z) * rn, bfhi(b.z) * rn, w3, false); w3 = __builtin_amdgcn_cvt_pk_fp8_f32(bflo(b.w) * rn, bfhi(b.w) * rn, w3, true);
                const v4u o = {(unsigned)w0, (unsigned)w1, (unsigned)w2, (unsigned)w3};
                *((GAS v4u*)((unsigned char*)AS + (size_t)s1 * MOE8_PITCH) + F.lane) = o; *((GAS v4u*)((unsigned char*)AS + (size_t)s2 * MOE8_PITCH) + F.lane) = o;
            } else {
            const GAS v4u* src = (const GAS v4u*)(XB + (size_t)t * DM) + F.lane; const v4u a = src[0], b = src[64];
            GAS v4u* d1 = (GAS v4u*)(AS + (size_t)s1 * DM) + F.lane; GAS v4u* d2 = (GAS v4u*)(AS + (size_t)s2 * DM) + F.lane;
            d1[0] = a; d1[64] = b; d2[0] = a; d2[64] = b; } }
        __syncthreads();
    }
}

__device__ __forceinline__ void cb_phase(const Frame& F, int lp) {
    const int* tok_slot = (const int*)fact(F, FA_SLOT + SL_TOKSLOT); const bf16* Y = (const bf16*)fact(F, FA_Y); bf16* XB = (bf16*)fact(F, FA_XB);
    fx64* ssq = ssq_arr(F, lp == 0 ? 4 : 7);
    const int gw = F.vcu * NWAVES + F.wave, NGW = F.G * NWAVES;
    for (int m = gw; m < TT; m += NGW) {
        const int s1 = tok_slot[2 * m], s2 = tok_slot[2 * m + 1]; const float* r_w = (const float*)fact(F, FA_SLOT + SL_RW); const float g1 = r_w[2 * m], g2 = r_w[2 * m + 1];
        GAS f32x4* xr = (GAS f32x4*)(F.X + (size_t)m * DM) + F.lane; const GAS v2u* y1 = (const GAS v2u*)(Y + (size_t)s1 * DM) + F.lane; const GAS v2u* y2 = (const GAS v2u*)(Y + (size_t)s2 * DM) + F.lane;
        GAS v2u* o8 = (GAS v2u*)(XB + (size_t)m * DM) + F.lane; float s = 0.f;
#pragma unroll
        for (int j = 0; j < 4; ++j) { f32x4 v = xr[64 * j]; const v2u a = y1[64 * j], b = y2[64 * j];
            v.x += g1 * bflo(a.x) + g2 * bflo(b.x); v.y += g1 * bfhi(a.x) + g2 * bfhi(b.x); v.z += g1 * bflo(a.y) + g2 * bflo(b.y); v.w += g1 * bfhi(a.y) + g2 * bfhi(b.y);
            xr[64 * j] = v; s += (v.x * v.x + v.y * v.y) + (v.z * v.z + v.w * v.w);
            if (lp == 0) { v2u wv; wv.x = pk2(v.x, v.y); wv.y = pk2(v.z, v.w); o8[64 * j] = wv; } }
        if (lp == 0) { s = wave_sum(s, F.lane); if (F.lane == 0) ssq[m] = fx_of(s); }
    }
}

namespace pg8 {
struct MoeOrder {
    int np[8], ps[8]; int ntile, U, G, c; long astep, bstep; int probe_same;
    __device__ __forceinline__ void init(const MoeSeg& s, int ntile_, int G_, int c_, int lda, int ldb) {
#pragma unroll
        for (int e = 0; e < 8; ++e) { np[e] = s.np[e]; ps[e] = s.ps[e]; }
        ntile = ntile_; U = s.total * ntile_; G = G_; c = c_; astep = (long)BM * lda * 2; bstep = (long)BM * ldb * 2; probe_same = 0; }
    __device__ __forceinline__ bool next(int i, Unit& u) const {
        const int L = i * G + c; if (L >= U) return false;
        int wgid = (int)L; { const int q = U / NXCD, r = U % NXCD, xcd = wgid % NXCD, off = wgid / NXCD; wgid = (xcd < r ? xcd * (q + 1) : r * (q + 1) + (xcd - r) * q) + off; }
        int e = 0, li = wgid, npe = np[0], pse = ps[0];
#pragma unroll
        for (int k = 1; k < 8; ++k) { const int ue = npe * ntile; const bool adv = (e == k - 1) && (li >= ue); li = adv ? li - ue : li; e = adv ? k : e; npe = adv ? np[k] : npe; pse = adv ? ps[k] : pse; }
        const int nig = WGM * ntile, gid = li / nig, fm = gid * WGM, gsz = (npe - fm) < WGM ? (npe - fm) : WGM, rem = li % nig;
        u.pm = __builtin_amdgcn_readfirstlane(pse + fm + rem % gsz); u.pn = __builtin_amdgcn_readfirstlane(e * ntile + rem / gsz); u.aoff = u.pm * astep; u.boff = u.pn * bstep;
#ifdef PROBE_EXTRA
        if (probe_same & 1) u.boff = 0; if (probe_same & 2) u.aoff = 0;
#endif
        return true;
    }
    __device__ __forceinline__ void a_ready(const Unit&) const {}
    __device__ __forceinline__ void done(const Unit&) const {}
};
struct EpiScaleBf16 {
    static constexpr bool PERM = true, AFTER_DRAIN = false; static constexpr int NSTAT = 0;
    bf16_t* Y; int ldy; const float* rowscale; int tpg; float accscale;
    __device__ __forceinline__ void operator()(const f32x4 (&acc)[2][2][4][2], const Unit& u, int wr, int wc, int fr, int fq) const {
        const int row0 = u.pm * BM + wr * 64 + fr, col0 = (u.pn % tpg) * BM + wc * 32 + 8 * fq;
        float sc[2][4];
#pragma unroll
        for (int ai = 0; ai < 2; ++ai)
#pragma unroll
            for (int m = 0; m < 4; ++m) sc[ai][m] = rowscale ? rowscale[row0 + ai * HALF + m * 16] * accscale : accscale;
#pragma unroll
        for (int ai = 0; ai < 2; ++ai)
#pragma unroll
            for (int m = 0; m < 4; ++m) { const int row = row0 + ai * HALF + m * 16; const float s = sc[ai][m];
#pragma unroll
                for (int bj = 0; bj < 2; ++bj) { const f32x4 v0 = acc[ai][bj][m][0] * s, v1 = acc[ai][bj][m][1] * s;
                    u32x4 w; w.x = pk2(v0[0], v0[1]); w.y = pk2(v0[2], v0[3]); w.z = pk2(v1[0], v1[1]); w.w = pk2(v1[2], v1[3]);
                    *(u32x4*)(Y + (size_t)row * ldy + col0 + bj * HALF) = w; } }
    }
};
struct EpiNull {
    static constexpr bool PERM = true, AFTER_DRAIN = false; static constexpr int NSTAT = 0; bf16_t* O;
    __device__ __forceinline__ void operator()(const f32x4 (&acc)[2][2][4][2], const Unit& u, int wr, int wc, int fr, int fq) const {
        float s = 0.f;
#pragma unroll
        for (int ai = 0; ai < 2; ++ai)
#pragma unroll
            for (int bj = 0; bj < 2; ++bj)
#pragma unroll
                for (int m = 0; m < 4; ++m)
#pragma unroll
                    for (int n = 0; n < 2; ++n) s += acc[ai][bj][m][n][0] + acc[ai][bj][m][n][1] + acc[ai][bj][m][n][2] + acc[ai][bj][m][n][3];
        if (s == 1.2345678e30f) O[u.pm * 256 + fr] = 1; }
};
}
__device__ __forceinline__ float gelu_tanh_f(float x) { const float u = 0.7978845608028654f * (x + 0.044715f * x * x * x); const float t = __builtin_amdgcn_exp2f(u * 2.8853900817779268f); return 0.5f * x * (2.f - 2.f * fast_rcp(1.f + t)); }

__device__ __forceinline__ void conv_phase(const Frame& F, int lp) {
    const bf16* XBR = (const bf16*)fact(F, FA_XBR); bf16* XC = (bf16*)fact(F, FA_XC); const float* cw = FIN(14) + lp * 4096; const float* cb = FIN(15) + lp * 1024;
    const int gt = (F.vcu * NWAVES + F.wave) * 64 + F.lane, NGT = F.G * NWAVES * 64;
    for (int it = gt; it < (TT / 16) * 128; it += NGT) {
        const int cg = it & 127, t0 = (it >> 7) * 16, c0 = cg * 8;
        float w[4][8], bsv[8];
#pragma unroll
        for (int j = 0; j < 4; ++j) { const f32x4 a = *(const f32x4*)(cw + j * 1024 + c0), b = *(const f32x4*)(cw + j * 1024 + c0 + 4); w[j][0] = a.x; w[j][1] = a.y; w[j][2] = a.z; w[j][3] = a.w; w[j][4] = b.x; w[j][5] = b.y; w[j][6] = b.z; w[j][7] = b.w; }
        { const f32x4 a = *(const f32x4*)(cb + c0), b = *(const f32x4*)(cb + c0 + 4); bsv[0] = a.x; bsv[1] = a.y; bsv[2] = a.z; bsv[3] = a.w; bsv[4] = b.x; bsv[5] = b.y; bsv[6] = b.z; bsv[7] = b.w; }
        float h0[8], h1[8], h2[8];
        const bool first = (t0 & (SEQL - 1)) == 0;
        auto ld = [&](int t, float (&o)[8]) { const v4u v = *(const GAS v4u*)(XBR + (size_t)t * DM + c0); o[0] = bflo(v.x); o[1] = bfhi(v.x); o[2] = bflo(v.y); o[3] = bfhi(v.y); o[4] = bflo(v.z); o[5] = bfhi(v.z); o[6] = bflo(v.w); o[7] = bfhi(v.w); };
        if (first) {
#pragma unroll
            for (int k = 0; k < 8; ++k) { h0[k] = 0.f; h1[k] = 0.f; h2[k] = 0.f; }
        } else { ld(t0 - 3, h0); ld(t0 - 2, h1); ld(t0 - 1, h2); }
#pragma unroll 4
        for (int i = 0; i < 16; ++i) { float cur[8]; ld(t0 + i, cur); float o[8];
#pragma unroll
            for (int k = 0; k < 8; ++k) { o[k] = bsv[k] + h0[k] * w[0][k] + h1[k] * w[1][k] + h2[k] * w[2][k] + cur[k] * w[3][k]; h0[k] = h1[k]; h1[k] = h2[k]; h2[k] = cur[k]; }
            v4u ov; ov.x = pk2(o[0], o[1]); ov.y = pk2(o[2], o[3]); ov.z = pk2(o[4], o[5]); ov.w = pk2(o[6], o[7]);
            *(GAS v4u*)(XC + (size_t)(t0 + i) * DM + c0) = ov; }
    }
}

__device__ __forceinline__ void scan_phase(const Frame& F, int lp) {
    const bf16* RA = (const bf16*)fact(F, FA_LA); const bf16* RI = (const bf16*)fact(F, FA_U); const bf16* XC = (const bf16*)fact(F, FA_XC); const bf16* G = (const bf16*)fact(F, FA_G); bf16* YG = (bf16*)fact(F, FA_YG);
    const float* coefp = (const float*)fact(F, FA_COEF) + lp * 1024;
    LAS float* sA = (LAS float*)(F.lds + RING_OFF); LAS float* sH = sA + 128 * 32; LAS float* sC = sH + 128 * 32; LAS float* gA = sC + 128 * 32; LAS float* gH = gA + 16 * 32; LAS float* gC = gH + 16 * 32; LAS float* sEnd = gC + 16 * 32;
    const int cg = F.tid & 3, chunk = F.tid >> 2, cl = cg * 8;
    for (int wg = blockIdx.x; wg < 8 * 32; wg += F.G) {
        const int b = wg >> 5, c0 = (wg & 31) * 32 + cl;
        float coef[8]; { const f32x4 x0 = *(const f32x4*)(coefp + c0), x1 = *(const f32x4*)(coefp + c0 + 4); coef[0] = x0[0]; coef[1] = x0[1]; coef[2] = x0[2]; coef[3] = x0[3]; coef[4] = x1[0]; coef[5] = x1[1]; coef[6] = x1[2]; coef[7] = x1[3]; }
        if (F.tid < 32) sEnd[F.tid] = 0.f;
        for (int half = 0; half < 2; ++half) {
            const size_t base = ((size_t)b * SEQL + half * 1024 + chunk * 8) * DM + c0;
            v4u lav[8], uv[8]; float ap[8], hh[8];
#pragma unroll
            for (int k = 0; k < 8; ++k) { ap[k] = 1.f; hh[k] = 0.f; }
            size_t off = base;
            v4u ra[8], ri[8], xc[8];
#pragma unroll
            for (int s0 = 0; s0 < 8; s0 += 2) {
                asm volatile("" : "+v"(off) :: "memory");
#pragma unroll
                for (int s = 0; s < 2; ++s) { const size_t o = off + (size_t)s * DM; ra[s0 + s] = *(const GAS v4u*)(RA + o); ri[s0 + s] = *(const GAS v4u*)(RI + o); xc[s0 + s] = *(const GAS v4u*)(XC + o); }
                off += 2 * DM; }
#pragma unroll
            for (int s = 0; s < 8; ++s) { unsigned lw[4], uw[4];
#pragma unroll
                    for (int q = 0; q < 4; ++q) { float l2[2], uu[2];
#pragma unroll
                        for (int e = 0; e < 2; ++e) { const unsigned wa = ra[s][q], wi = ri[s][q], wx = xc[s][q]; const float fa = e ? bfhi(wa) : bflo(wa), fi = e ? bfhi(wi) : bflo(wi), fx = e ? bfhi(wx) : bflo(wx);
                            const float r = sigm_f(fa), ig = sigm_f(fi); l2[e] = coef[2 * q + e] * r; uu[e] = ig * fx; }
                        const unsigned lp2 = pk2(l2[0], l2[1]);
#pragma unroll
                        for (int e = 0; e < 2; ++e) { const float lb = e ? bfhi(lp2) : bflo(lp2); const float z = lb * 1.3862943611198906f;
                            const float ser = -z * (1.f + z * (0.5f + z * (0.16666667f + z * 0.041666668f))), ex = 1.f - __builtin_amdgcn_exp2f(2.f * lb); const float om = (z > -0.1f) ? ser : ex;
                            uu[e] *= __builtin_amdgcn_sqrtf(fmaxf(om, 0.f)); }
                        const unsigned up2 = pk2(uu[0], uu[1]); lw[q] = lp2; uw[q] = up2;
#pragma unroll
                        for (int e = 0; e < 2; ++e) { const float a = __builtin_amdgcn_exp2f(e ? bfhi(lp2) : bflo(lp2)), ub = e ? bfhi(up2) : bflo(up2); hh[2 * q + e] = a * hh[2 * q + e] + ub; ap[2 * q + e] *= a; } }
                    lav[s] = (v4u){lw[0], lw[1], lw[2], lw[3]}; uv[s] = (v4u){uw[0], uw[1], uw[2], uw[3]}; }
            v4u gg[8];
            off = base;
#pragma unroll
            for (int s0 = 0; s0 < 8; s0 += 4) {
                asm volatile("" : "+v"(off) :: "memory");
#pragma unroll
                for (int s = 0; s < 4; ++s) gg[s0 + s] = *(const GAS v4u*)(G + off + (size_t)s * DM);
                off += 4 * DM; }
#pragma unroll
            for (int k = 0; k < 8; ++k) { sA[chunk * 32 + cl + k] = ap[k]; sH[chunk * 32 + cl + k] = hh[k]; }
            __syncthreads();
            { const int ch = F.tid & 31, grp = F.tid >> 5;
              float a = 1.f, h = 0.f;
              for (int i = 0; i < 8; ++i) { const int c = grp * 8 + i; const float ca = sA[c * 32 + ch], chh = sH[c * 32 + ch]; h = ca * h + chh; a *= ca; }
              gA[grp * 32 + ch] = a; gH[grp * 32 + ch] = h; }
            __syncthreads();
            if (F.tid < 32) { float c = sEnd[F.tid]; for (int g2 = 0; g2 < 16; ++g2) { gC[g2 * 32 + F.tid] = c; c = gA[g2 * 32 + F.tid] * c + gH[g2 * 32 + F.tid]; } sEnd[F.tid] = c; }
            __syncthreads();
            { const int ch = F.tid & 31, grp = F.tid >> 5; float c = gC[grp * 32 + ch];
              for (int i = 0; i < 8; ++i) { const int cc = grp * 8 + i; sC[cc * 32 + ch] = c; c = sA[cc * 32 + ch] * c + sH[cc * 32 + ch]; } }
            __syncthreads();
#pragma unroll
            for (int k = 0; k < 8; ++k) hh[k] = sC[chunk * 32 + cl + k];
            off = base;
#pragma unroll
            for (int s0 = 0; s0 < 8; s0 += 4) {
                asm volatile("" : "+v"(off) :: "memory");
#pragma unroll
                for (int s = 0; s < 4; ++s) { unsigned ow[4];
#pragma unroll
                    for (int q = 0; q < 4; ++q) { float y[2];
#pragma unroll
                        for (int e = 0; e < 2; ++e) { const unsigned lw = lav[s0 + s][q], uw = uv[s0 + s][q], gw = gg[s0 + s][q]; const float a = __builtin_amdgcn_exp2f(e ? bfhi(lw) : bflo(lw)), ub = e ? bfhi(uw) : bflo(uw);
                            hh[2 * q + e] = a * hh[2 * q + e] + ub; y[e] = hh[2 * q + e] * (e ? bfhi(gw) : bflo(gw)); }
                        ow[q] = pk2(y[0], y[1]); }
                    *(GAS v4u*)(YG + off + (size_t)s * DM) = (v4u){ow[0], ow[1], ow[2], ow[3]}; }
                off += 4 * DM;
            }
            __syncthreads();
        }
    }
}

namespace pg8 {
struct GateOrder {
    int G, c;
    __device__ __forceinline__ bool next(int i, Unit& u) const {
        const int L = i * G + c; if (L >= 512) return false;
        u.pm = L >> 3; u.pn = L & 7; u.aoff = (long)u.pm * (BM * 1024 * 2) + u.pn * 256; u.boff = (long)u.pn * (256 * WG_LD * 2); return true; }
    __device__ __forceinline__ void a_ready(const Unit&) const {}
    __device__ __forceinline__ void done(const Unit&) const {}
};
struct EpiLruIn {
    static constexpr bool PERM = true, AFTER_DRAIN = false; static constexpr int NSTAT = 2;
    bf16_t* Gt; bf16_t* XBR; const fx64* ssq; const float* bias;
    __device__ __forceinline__ const void* tab_src(int k, const Unit& u) const { return k == 0 ? (const void*)(ssq + (size_t)u.pm * BM) : (const void*)(bias + u.pn * BM); }
    __device__ __forceinline__ int tab_bytes(int k) const { return k == 0 ? 2048 : 1024; }
    __device__ __forceinline__ void operator()(const f32x4 (&acc)[2][2][4][2], const Unit& u, int wr, int wc, int fr, int fq, const PG8_LAS unsigned char* tab) const {
        const int row0 = u.pm * BM + wr * 64 + fr, colg = u.pn * BM + wc * 32 + 8 * fq; const bool gate = u.pn < 4; bf16_t* O = gate ? Gt : XBR; const int col0 = colg & 1023;
        f32x4 bv[2][2];
#pragma unroll
        for (int bj = 0; bj < 2; ++bj)
#pragma unroll
            for (int n = 0; n < 2; ++n) bv[bj][n] = *(const PG8_LAS f32x4*)(tab + 2048 + (wc * 32 + 8 * fq + bj * HALF + 4 * n) * 4);
        float rsv[2][4];
#pragma unroll
        for (int ai = 0; ai < 2; ++ai)
#pragma unroll
            for (int m = 0; m < 4; ++m) rsv[ai][m] = fx_to(*(const PG8_LAS unsigned long long*)(tab + (wr * 64 + fr + ai * HALF + m * 16) * 8));
#pragma unroll
        for (int ai = 0; ai < 2; ++ai)
#pragma unroll
            for (int m = 0; m < 4; ++m) { const int row = row0 + ai * HALF + m * 16; const float rs = rstd_of(rsv[ai][m], 1.f / 1024.f);
#pragma unroll
                for (int bj = 0; bj < 2; ++bj) { f32x4 v0 = acc[ai][bj][m][0] * rs + bv[bj][0], v1 = acc[ai][bj][m][1] * rs + bv[bj][1];
                    if (gate) {
#pragma unroll
                        for (int j = 0; j < 4; ++j) { v0[j] = gelu_tanh_f(v0[j]); v1[j] = gelu_tanh_f(v1[j]); } }
                    u32x4 w; w.x = pk2(v0[0], v0[1]); w.y = pk2(v0[2], v0[3]); w.z = pk2(v1[0], v1[1]); w.w = pk2(v1[2], v1[3]);
                    *(u32x4*)(O + (size_t)row * DM + col0 + bj * HALF) = w; } }
    }
};
struct EpiGates {
    static constexpr bool PERM = true, AFTER_DRAIN = false; static constexpr int NSTAT = 2;
    bf16_t* RA; bf16_t* RI; const float* ba; const float* bi;
    __device__ __forceinline__ const void* tab_src(int k, const Unit& u) const { return (k == 0 ? ba : bi) + u.pn * 128; }
    __device__ __forceinline__ int tab_bytes(int) const { return 512; }
    __device__ __forceinline__ void operator()(const f32x4 (&acc)[2][2][4][2], const Unit& u, int wr, int wc, int fr, int fq, const PG8_LAS unsigned char* tab) const {
        const int row0 = u.pm * BM + wr * 64 + fr, ch0 = u.pn * 128 + wc * 32 + 8 * fq;
        const int cl = (wc * 32 + 8 * fq) * 4; const f32x4 a0 = *(const PG8_LAS f32x4*)(tab + cl), a1 = *(const PG8_LAS f32x4*)(tab + cl + 16), b0 = *(const PG8_LAS f32x4*)(tab + 2048 + cl), b1 = *(const PG8_LAS f32x4*)(tab + 2048 + cl + 16);
#pragma unroll
        for (int ai = 0; ai < 2; ++ai)
#pragma unroll
            for (int m = 0; m < 4; ++m) { const int row = row0 + ai * HALF + m * 16;
                { const f32x4 v0 = acc[ai][0][m][0] + a0, v1 = acc[ai][0][m][1] + a1; u32x4 w; w.x = pk2(v0[0], v0[1]); w.y = pk2(v0[2], v0[3]); w.z = pk2(v1[0], v1[1]); w.w = pk2(v1[2], v1[3]); *(u32x4*)(RA + (size_t)row * DM + ch0) = w; }
                { const f32x4 v0 = acc[ai][1][m][0] + b0, v1 = acc[ai][1][m][1] + b1; u32x4 w; w.x = pk2(v0[0], v0[1]); w.y = pk2(v0[2], v0[3]); w.z = pk2(v1[0], v1[1]); w.w = pk2(v1[2], v1[3]); *(u32x4*)(RI + (size_t)row * DM + ch0) = w; } }
    }
};
}
constexpr int KIMG = 24576, VIMG = 16384;
__device__ __forceinline__ int v_st(int k, int c) { const int kk = (k & ~0xC) | ((k & 4) << 1) | ((k & 8) >> 1); return ((kk >> 3) * 4 + (c >> 5)) * 512 + ((kk & 7) * 32 + (c & 31)) * 2; }
__device__ __forceinline__ int v_rd_base(int lane) { return ((lane & 3) << 3) | (((lane >> 2) & 3) << 6) | (((lane >> 4) & 1) << 5) | (((lane >> 5) & 1) << 8); }
constexpr int v_rd_off(int d0, int ks, int half) { return d0 * 512 + ks * 4096 + half * 2048; }

namespace pg8 {
struct EpiMlaIn {
    static constexpr bool PERM = true, AFTER_DRAIN = false; static constexpr int NSTAT = 1;
    bf16_t* CQ; bf16_t* CKV; float* KR; const fx64* ssq; fx64* ssq_cq; fx64* ssq_ckv; fx64* ssq_kr; const float* gkn; const float* cs;
    __device__ __forceinline__ const void* tab_src(int, const Unit& u) const { return ssq + (size_t)u.pm * BM; }
    __device__ __forceinline__ int tab_bytes(int) const { return 2048; }
    __device__ __forceinline__ void operator()(const f32x4 (&acc)[2][2][4][2], const Unit& u, int wr, int wc, int fr, int fq, const PG8_LAS unsigned char* tab) const {
        const int row0 = u.pm * BM + wr * 64 + fr;
        float rsv[2][4];
#pragma unroll
        for (int ai = 0; ai < 2; ++ai)
#pragma unroll
            for (int m = 0; m < 4; ++m) rsv[ai][m] = fx_to(*(const PG8_LAS unsigned long long*)(tab + (wr * 64 + fr + ai * HALF + m * 16) * 8));
#pragma unroll
        for (int bj = 0; bj < 2; ++bj) {
            const int seg = u.pn * 2 + bj;
            if (seg < 5) {
                bf16_t* O = seg < 3 ? CQ : CKV; const int ld = seg < 3 ? CQ_LD : CKV_LD; const int col0 = (seg < 3 ? seg : seg - 3) * 128 + wc * 32 + 8 * fq; fx64* sq = seg < 3 ? ssq_cq : ssq_ckv;
#pragma unroll
                for (int ai = 0; ai < 2; ++ai)
#pragma unroll
                    for (int m = 0; m < 4; ++m) { const int row = row0 + ai * HALF + m * 16; const float rs = rstd_of(rsv[ai][m], 1.f / 1024.f);
                        const f32x4 v0 = acc[ai][bj][m][0] * rs, v1 = acc[ai][bj][m][1] * rs;
                        float s = (v0[0] * v0[0] + v0[1] * v0[1]) + (v0[2] * v0[2] + v0[3] * v0[3]) + (v1[0] * v1[0] + v1[1] * v1[1]) + (v1[2] * v1[2] + v1[3] * v1[3]);
                        u32x4 w; w.x = pk2(v0[0], v0[1]); w.y = pk2(v0[2], v0[3]); w.z = pk2(v1[0], v1[1]); w.w = pk2(v1[2], v1[3]);
                        *(u32x4*)(O + (size_t)row * ld + col0) = w;
                        { const int ln_ = fq * 16 + fr; s += xshfl(s, 16, ln_); s += xshfl(s, 32, ln_); } if (fq == 0) fx_add(sq + row, s); }
            } else if (wc < 2) {
                const int idx0 = 16 * wc + 4 * fq; const f32x4 g1 = *(const f32x4*)(gkn + 128 + idx0), g2 = *(const f32x4*)(gkn + 160 + idx0);
#pragma unroll
                for (int ai = 0; ai < 2; ++ai)
#pragma unroll
                    for (int m = 0; m < 4; ++m) { const int row = row0 + ai * HALF + m * 16; const float rs = rstd_of(rsv[ai][m], 1.f / 1024.f);
                        const f32x4 x1 = acc[ai][bj][m][0] * rs, x2 = acc[ai][bj][m][1] * rs;
                        float s = (x1[0] * x1[0] + x1[1] * x1[1]) + (x1[2] * x1[2] + x1[3] * x1[3]) + (x2[0] * x2[0] + x2[1] * x2[1]) + (x2[2] * x2[2] + x2[3] * x2[3]);
                        const f32x4 c = *(const f32x4*)(cs + (size_t)row * 32 + idx0), sn = *(const f32x4*)(cs + (size_t)TT * 32 + (size_t)row * 32 + idx0);
                        const f32x4 a = x1 * g1, b = x2 * g2; const f32x4 y1 = a * c - b * sn, y2 = a * sn + b * c;
                        *(f32x4*)(KR + (size_t)row * 64 + idx0) = y1; *(f32x4*)(KR + (size_t)row * 64 + 32 + idx0) = y2;
                        { const int ln_ = fq * 16 + fr; s += xshfl(s, 16, ln_); s += xshfl(s, 32, ln_); } if (fq == 0) fx_add(ssq_kr + row, s); }
            }
        }
    }
};
struct EpiKV {
    static constexpr bool PERM = true, AFTER_DRAIN = false; static constexpr int NSTAT = 2;
    unsigned char* Kimg; unsigned char* Vimg; const float* KR; const fx64* ssq_ckv; const fx64* ssq_kr; const float* gkn; PG8_LAS float* xch;
    __device__ __forceinline__ const void* tab_src(int k, const Unit& u) const { return (k == 0 ? ssq_ckv : ssq_kr) + (size_t)u.pm * BM; }
    __device__ __forceinline__ int tab_bytes(int) const { return 2048; }
    __device__ __forceinline__ void operator()(const f32x4 (&acc)[2][2][4][2], const Unit& u, int wr, int wc, int fr, int fq, const PG8_LAS unsigned char* tab) const {
        const int rl0 = wr * 64 + fr, row0 = u.pm * BM + rl0, h = u.pn;
        const int c0 = wc * 32 + 8 * fq; const f32x4 g0 = *(const f32x4*)(gkn + c0), g1 = *(const f32x4*)(gkn + c0 + 4);
        f32x4 krv[2][4];
#pragma unroll
        for (int ai = 0; ai < 2; ++ai)
#pragma unroll
            for (int m = 0; m < 4; ++m) krv[ai][m] = *(const f32x4*)(KR + (size_t)(row0 + ai * HALF + m * 16) * 64 + 16 * wc + 4 * fq);
        float rsv[2][4], skr[2][4];
#pragma unroll
        for (int ai = 0; ai < 2; ++ai)
#pragma unroll
            for (int m = 0; m < 4; ++m) { rsv[ai][m] = fx_to(*(const PG8_LAS unsigned long long*)(tab + (rl0 + ai * HALF + m * 16) * 8)); skr[ai][m] = fx_to(*(const PG8_LAS unsigned long long*)(tab + 2048 + (rl0 + ai * HALF + m * 16) * 8)); }
#pragma unroll
        for (int ai = 0; ai < 2; ++ai)
#pragma unroll
            for (int m = 0; m < 4; ++m) { const float rs = rstd_of(rsv[ai][m], 1.f / 256.f); rsv[ai][m] = rs; const f32x4 v0 = acc[ai][0][m][0] * rs, v1 = acc[ai][0][m][1] * rs;
                float s = (v0[0] * v0[0] + v0[1] * v0[1]) + (v0[2] * v0[2] + v0[3] * v0[3]) + (v1[0] * v1[0] + v1[1] * v1[1]) + (v1[2] * v1[2] + v1[3] * v1[3]);
                { const int ln_ = fq * 16 + fr; s += xshfl(s, 16, ln_); s += xshfl(s, 32, ln_); } if (fq == 0) xch[(rl0 + ai * HALF + m * 16) * 4 + wc] = s; }
        asm volatile("s_waitcnt lgkmcnt(0)" ::: "memory"); __builtin_amdgcn_s_barrier(); asm volatile("" ::: "memory");
        const int b = (u.pm * BM) >> 11;
#pragma unroll
        for (int ai = 0; ai < 2; ++ai)
#pragma unroll
            for (int m = 0; m < 4; ++m) { const int rl = rl0 + ai * HALF + m * 16, row = u.pm * BM + rl; const f32x4 pp = *(const PG8_LAS f32x4*)(xch + rl * 4);
                const float rk = rstd_of((pp[0] + pp[1]) + (pp[2] + pp[3]) + skr[ai][m], 1.f / 192.f); const float rs = rsv[ai][m];
                const int ts = row & 2047, tile = ts >> 6, key = ts & 63; const size_t ibase = ((size_t)(b * 8 + h) * 32 + tile);
                unsigned char* kb = Kimg + ibase * KIMG + key * 16; unsigned char* vb = Vimg + ibase * VIMG;
                { const f32x4 v0 = acc[ai][0][m][0] * (rs * rk) * g0, v1 = acc[ai][0][m][1] * (rs * rk) * g1;
                  u32x4 w; w.x = pk2(v0[0], v0[1]); w.y = pk2(v0[2], v0[3]); w.z = pk2(v1[0], v1[1]); w.w = pk2(v1[2], v1[3]);
                  *(u32x4*)(kb + (4 * wc + fq) * 1024) = w; }
                { const f32x4 kr = krv[ai][m] * rk; v2u w; w.x = pk2(kr[0], kr[1]); w.y = pk2(kr[2], kr[3]);
                  *(v2u*)(kb + (16 + 2 * wc + (fq >> 1)) * 1024 + (fq & 1) * 8) = w; }
                { const f32x4 v0 = acc[ai][1][m][0] * rs, v1 = acc[ai][1][m][1] * rs;
                  u32x4 w; w.x = pk2(v0[0], v0[1]); w.y = pk2(v0[2], v0[3]); w.z = pk2(v1[0], v1[1]); w.w = pk2(v1[2], v1[3]);
                  *(u32x4*)(vb + v_st(key, c0)) = w; } }
    }
};
struct EpiRstdBf16 {
    static constexpr bool PERM = true, AFTER_DRAIN = false; static constexpr int NSTAT = 1;
    bf16_t* O; int ldo; const fx64* ssq; float invn;
    __device__ __forceinline__ const void* tab_src(int, const Unit& u) const { return ssq + (size_t)u.pm * BM; }
    __device__ __forceinline__ int tab_bytes(int) const { return 2048; }
    __device__ __forceinline__ void operator()(const f32x4 (&acc)[2][2][4][2], const Unit& u, int wr, int wc, int fr, int fq, const PG8_LAS unsigned char* tab) const {
        const int row0 = u.pm * BM + wr * 64 + fr, col0 = u.pn * BM + wc * 32 + 8 * fq;
        float sc[2][4];
#pragma unroll
        for (int ai = 0; ai < 2; ++ai)
#pragma unroll
            for (int m = 0; m < 4; ++m) sc[ai][m] = fx_to(*(const PG8_LAS unsigned long long*)(tab + (wr * 64 + fr + ai * HALF + m * 16) * 8));
#pragma unroll
        for (int ai = 0; ai < 2; ++ai)
#pragma unroll
            for (int m = 0; m < 4; ++m) { const int row = row0 + ai * HALF + m * 16; const float s = rstd_of(sc[ai][m], invn);
#pragma unroll
                for (int bj = 0; bj < 2; ++bj) { const f32x4 v0 = acc[ai][bj][m][0] * s, v1 = acc[ai][bj][m][1] * s;
                    u32x4 w; w.x = pk2(v0[0], v0[1]); w.y = pk2(v0[2], v0[3]); w.z = pk2(v1[0], v1[1]); w.w = pk2(v1[2], v1[3]);
                    *(u32x4*)(O + (size_t)row * ldo + col0 + bj * HALF) = w; } }
    }
};
}

namespace att {
using f32x16 = __attribute__((ext_vector_type(16))) float;
using s16x4 = __attribute__((ext_vector_type(4))) short;
constexpr int SLOTB = KIMG + VIMG, NSLOT = 3;
static_assert(NSLOT * SLOTB <= RING_BYTES, "attention ring");
constexpr float C2 = 0.07216878364870322f * 1.4426950408889634f;
constexpr float THR2 = 8.f;
__device__ __forceinline__ int crow(int r, int hi) { return (r & 3) + 8 * (r >> 2) + 4 * hi; }
__device__ __forceinline__ void glds16(const void* gsrc, unsigned lds_dst) { unsigned keep;
    asm volatile("s_mov_b32 %0, m0\n\ts_mov_b32 m0, %2\n\ts_nop 0\n\tglobal_load_lds_dwordx4 %1, off\n\ts_mov_b32 m0, %0" : "=&s"(keep) : "v"(gsrc), "s"(lds_dst) : "memory"); }
template <int OFF> __device__ __forceinline__ s16x4 tr_read(int vb) { s16x4 r; asm volatile("ds_read_b64_tr_b16 %0, %1 offset:%2" : "=&v"(r) : "v"(vb), "i"(OFF) : "memory"); return r; }
template <int D0> __device__ __forceinline__ void pv_one(f32x16& od, int vb, bf16x8 pa0, bf16x8 pa1, bf16x8 pa2, bf16x8 pa3) {
    const s16x4 l0 = tr_read<v_rd_off(D0, 0, 0)>(vb), h0 = tr_read<v_rd_off(D0, 0, 1)>(vb), l1 = tr_read<v_rd_off(D0, 1, 0)>(vb), h1 = tr_read<v_rd_off(D0, 1, 1)>(vb);
    const s16x4 l2 = tr_read<v_rd_off(D0, 2, 0)>(vb), h2 = tr_read<v_rd_off(D0, 2, 1)>(vb), l3 = tr_read<v_rd_off(D0, 3, 0)>(vb), h3 = tr_read<v_rd_off(D0, 3, 1)>(vb);
    asm volatile("s_waitcnt lgkmcnt(0)" ::: "memory"); __builtin_amdgcn_sched_barrier(0);
#define ATT_PK(L, H) (bf16x8){L[0], L[1], L[2], L[3], H[0], H[1], H[2], H[3]}
    od = __builtin_amdgcn_mfma_f32_32x32x16_bf16(pa0, ATT_PK(l0, h0), od, 0, 0, 0);
    od = __builtin_amdgcn_mfma_f32_32x32x16_bf16(pa1, ATT_PK(l1, h1), od, 0, 0, 0);
    od = __builtin_amdgcn_mfma_f32_32x32x16_bf16(pa2, ATT_PK(l2, h2), od, 0, 0, 0);
    od = __builtin_amdgcn_mfma_f32_32x32x16_bf16(pa3, ATT_PK(l3, h3), od, 0, 0, 0);
#undef ATT_PK
}
__device__ __forceinline__ void attn_unit(const Frame& F, int lp, int b, int h, int qb) {
    const int lane = F.lane, r32 = lane & 31, hi = lane >> 5, wid = F.wave;
    const bf16* Q = (const bf16*)fact(F, FA_Q); bf16* O = (bf16*)fact(F, FA_O); const float* cs = (const float*)fact(F, FA_ROPE); const float* gqn = FIN(9) + lp * 192;
    const unsigned char* Kimg = fact(F, FA_K) + (size_t)(b * 8 + h) * 32 * KIMG; const unsigned char* Vimg = fact(F, FA_V) + (size_t)(b * 8 + h) * 32 * VIMG;
    LAS unsigned char* ring = F.lds + RING_OFF; const unsigned ring0 = (unsigned)(uintptr_t)ring;
    LAS float* wsf = (LAS float*)(F.lds + XCH_OFF) + wid * 64;
    const int t0 = b * SEQL + qb * 256 + wid * 32, row = t0 + r32;
    bf16x8 qr[12];
    { const bf16* qp = Q + (size_t)row * 1536 + h * 192 + 8 * hi; v4u raw[12]; float s = 0.f;
#pragma unroll
      for (int d0 = 0; d0 < 12; ++d0) raw[d0] = *(const GAS v4u*)(qp + 16 * d0);
#pragma unroll
      for (int d0 = 0; d0 < 12; ++d0) { const v4u v = raw[d0]; const float a0 = bflo(v.x), a1 = bfhi(v.x), a2 = bflo(v.y), a3 = bfhi(v.y), a4 = bflo(v.z), a5 = bfhi(v.z), a6 = bflo(v.w), a7 = bfhi(v.w);
          s += (a0 * a0 + a1 * a1) + (a2 * a2 + a3 * a3) + (a4 * a4 + a5 * a5) + (a6 * a6 + a7 * a7); }
      s += xshfl(s, 32, lane); const float rq = rstd_of(s, 1.f / 192.f) * C2;
      auto unpack = [&](const v4u v, const float* gp, float (&o)[8]) { const f32x4 g0 = *(const f32x4*)gp, g1 = *(const f32x4*)(gp + 4);
          o[0] = bflo(v.x) * rq * g0[0]; o[1] = bfhi(v.x) * rq * g0[1]; o[2] = bflo(v.y) * rq * g0[2]; o[3] = bfhi(v.y) * rq * g0[3]; o[4] = bflo(v.z) * rq * g1[0]; o[5] = bfhi(v.z) * rq * g1[1]; o[6] = bflo(v.w) * rq * g1[2]; o[7] = bfhi(v.w) * rq * g1[3]; };
      auto pack = [&](const float (&o)[8]) { v4u w; w.x = pk2(o[0], o[1]); w.y = pk2(o[2], o[3]); w.z = pk2(o[4], o[5]); w.w = pk2(o[6], o[7]); return __builtin_bit_cast(bf16x8, w); };
#pragma unroll
      for (int d0 = 0; d0 < 8; ++d0) { float o[8]; unpack(raw[d0], gqn + 16 * d0 + 8 * hi, o); qr[d0] = pack(o); asm volatile("" : "+v"(qr[d0])); }
#pragma unroll
      for (int d0 = 8; d0 < 10; ++d0) { float x1[8], x2[8]; unpack(raw[d0], gqn + 16 * d0 + 8 * hi, x1); unpack(raw[d0 + 2], gqn + 16 * (d0 + 2) + 8 * hi, x2);
          const float* cp = cs + (size_t)row * 32 + 16 * (d0 - 8) + 8 * hi; const f32x4 c0 = *(const f32x4*)cp, c1 = *(const f32x4*)(cp + 4), s0 = *(const f32x4*)(cp + (size_t)TT * 32), s1 = *(const f32x4*)(cp + (size_t)TT * 32 + 4);
          float y1[8], y2[8];
#pragma unroll
          for (int j = 0; j < 8; ++j) { const float c = j < 4 ? c0[j] : c1[j - 4], sn = j < 4 ? s0[j] : s1[j - 4]; y1[j] = x1[j] * c - x2[j] * sn; y2[j] = x1[j] * sn + x2[j] * c; }
          qr[d0] = pack(y1); qr[d0 + 2] = pack(y2); asm volatile("" : "+v"(qr[d0]), "+v"(qr[d0 + 2])); } }
    const int ntb = 4 * qb + 4, my_nt = 4 * qb + (wid >> 1) + 1;
#define ATT_ISSUE(t, slot) do { _Pragma("unroll") for (int i_ = 0; i_ < 5; ++i_) { const int p_ = wid + 8 * i_; \
        const unsigned char* src_ = (p_ < 24) ? (Kimg + (size_t)(t) * KIMG + p_ * 1024) : (Vimg + (size_t)(t) * VIMG + (p_ - 24) * 1024); \
        glds16(src_ + lane * 16, (unsigned)__builtin_amdgcn_readfirstlane(ring0 + (slot) * SLOTB + p_ * 1024)); } } while (0)
    ATT_ISSUE(0, 0); ATT_ISSUE(1, 1);
    float m_reg = -1e30f, l_reg = 0.f; f32x16 o[4];
#pragma unroll
    for (int d = 0; d < 4; ++d) o[d] = f32x16{};
    int slot = 0;
    for (int t = 0; t < ntb; ++t) {
        if (t + 1 < ntb) asm volatile("s_waitcnt vmcnt(5)" ::: "memory"); else asm volatile("s_waitcnt vmcnt(0)" ::: "memory");
        asm volatile("s_waitcnt lgkmcnt(0)\n\ts_barrier" ::: "memory");
        if (t + 2 < ntb) { const int s2 = (slot + 2 >= NSLOT) ? slot + 2 - NSLOT : slot + 2; ATT_ISSUE(t + 2, s2); }
        if (t < my_nt) {
            const LAS unsigned char* Ks = ring + slot * SLOTB; const int vb = (int)(ring0 + slot * SLOTB + KIMG) + v_rd_base(lane);
            f32x16 p0 = f32x16{}, p1 = f32x16{};
#pragma unroll
            for (int d0 = 0; d0 < 12; ++d0) { const bf16x8 k0 = *(const LAS bf16x8*)(Ks + (2 * d0 + hi) * 1024 + r32 * 16), k1 = *(const LAS bf16x8*)(Ks + (2 * d0 + hi) * 1024 + 512 + r32 * 16);
                p0 = __builtin_amdgcn_mfma_f32_32x32x16_bf16(k0, qr[d0], p0, 0, 0, 0); p1 = __builtin_amdgcn_mfma_f32_32x32x16_bf16(k1, qr[d0], p1, 0, 0, 0); }
            float pmax = p0[0];
#pragma unroll
            for (int r = 1; r < 16; ++r) pmax = fmaxf(pmax, p0[r]);
#pragma unroll
            for (int r = 0; r < 16; ++r) pmax = fmaxf(pmax, p1[r]);
            { auto rr = __builtin_amdgcn_permlane32_swap(__float_as_uint(pmax), __float_as_uint(pmax), false, false); pmax = fmaxf(__uint_as_float(rr[0]), __uint_as_float(rr[1])); }
            float alpha = 1.f;
            if (!__all(pmax - m_reg <= THR2)) { const float mn = fmaxf(m_reg, pmax); alpha = __builtin_amdgcn_exp2f(m_reg - mn); m_reg = mn; }
            float ps = 0.f;
#pragma unroll
            for (int r = 0; r < 16; ++r) { p0[r] = __builtin_amdgcn_exp2f(p0[r] - m_reg); p1[r] = __builtin_amdgcn_exp2f(p1[r] - m_reg); ps += p0[r] + p1[r]; }
            { auto rr = __builtin_amdgcn_permlane32_swap(__float_as_uint(ps), __float_as_uint(ps), false, false); ps = __uint_as_float(rr[0]) + __uint_as_float(rr[1]); }
            l_reg = l_reg * alpha + ps;
            if (__any(alpha < 1.f)) { if (hi == 0) wsf[r32] = alpha; asm volatile("s_waitcnt lgkmcnt(0)" ::: "memory");
#pragma unroll
                for (int r = 0; r < 16; ++r) { const float a = wsf[crow(r, hi)];
#pragma unroll
                    for (int d = 0; d < 4; ++d) o[d][r] *= a; } }
            bf16x8 pa0, pa1, pa2, pa3;
#define ATT_PK4(P, BASE, OUT) do { unsigned a0 = pk2(P[BASE + 0], P[BASE + 1]), a1 = pk2(P[BASE + 2], P[BASE + 3]), b0 = pk2(P[BASE + 4], P[BASE + 5]), b1 = pk2(P[BASE + 6], P[BASE + 7]); \
        auto r0 = __builtin_amdgcn_permlane32_swap(a0, b0, false, false); auto r1 = __builtin_amdgcn_permlane32_swap(a1, b1, false, false); \
        v4u w_ = {r0[0], r1[0], r0[1], r1[1]}; OUT = __builtin_bit_cast(bf16x8, w_); } while (0)
            ATT_PK4(p0, 0, pa0); ATT_PK4(p0, 8, pa1); ATT_PK4(p1, 0, pa2); ATT_PK4(p1, 8, pa3);
#undef ATT_PK4
            pv_one<0>(o[0], vb, pa0, pa1, pa2, pa3); pv_one<1>(o[1], vb, pa0, pa1, pa2, pa3); pv_one<2>(o[2], vb, pa0, pa1, pa2, pa3); pv_one<3>(o[3], vb, pa0, pa1, pa2, pa3);
        }
        slot = (slot + 1 >= NSLOT) ? 0 : slot + 1;
    }
#undef ATT_ISSUE
    if (hi == 0) wsf[32 + r32] = l_reg;
    asm volatile("s_waitcnt lgkmcnt(0)\n\ts_barrier" ::: "memory");
    { LAS bf16* stg = (LAS bf16*)(ring + wid * 8704);
#pragma unroll
      for (int r = 0; r < 16; ++r) { const int orow = crow(r, hi); const float il = fast_rcp(wsf[32 + orow]);
#pragma unroll
          for (int d = 0; d < 4; ++d) stg[orow * 136 + 32 * d + r32] = (bf16)f2bf(o[d][r] * il); }
      asm volatile("s_waitcnt lgkmcnt(0)" ::: "memory");
      bf16* Ob = O + (size_t)t0 * DM + h * 128;
#pragma unroll
      for (int i = 0; i < 8; ++i) { const int p = lane + 64 * i, orow = p >> 4, c = p & 15; const v4u v = *(const LAS v4u*)(stg + orow * 136 + 8 * c); *(GAS v4u*)(Ob + (size_t)orow * DM + 8 * c) = v; } }
    asm volatile("s_waitcnt lgkmcnt(0)\n\ts_barrier" ::: "memory");
}
__device__ __forceinline__ void attn_phase(const Frame& F, int lp) {
    for (int v = F.vcu; v < 256; v += F.G) { const int bh = v >> 2, s = v & 3; attn_unit(F, lp, bh >> 3, bh & 7, s); attn_unit(F, lp, bh >> 3, bh & 7, 7 - s); }
}
}
#ifndef PROBE_DBG
#define PROBE_DBG 0
#endif
struct Args { const float* in[31]; float* out; unsigned char* ws; int ph_lo, ph_hi; };
enum { PH_M1 = 0, PH_M2, PH_ATT, PH_WO, PH_FU, PH_FD, PH_L1, PH_L2, PH_L3, PH_L4, PH_L5, PH_R1, PH_R2, PH_MU, PH_MD, PH_CB, PH_PER_PAIR = 20 };
constexpr int PH_PREP = 100;
constexpr int PH_END = 1 + PH_PER_PAIR + PH_CB + 1;

__global__ void __launch_bounds__(NWAVES * 64, 2) mega(Args args) {
    extern __shared__ __attribute__((aligned(16))) unsigned char lds[];
    Frame F;
    F.lds = (LAS unsigned char*)lds; F.MISC = (volatile LAS unsigned*)(F.lds + MISC_OFF);
    F.tid = threadIdx.x; F.lane = F.tid & 63; F.wave = __builtin_amdgcn_readfirstlane(F.tid >> 6);
    F.G = gridDim.x; { const int bx = blockIdx.x; F.vcu = (F.G % 8 == 0) ? (bx % 8) * (F.G / 8) + bx / 8 : bx; }
    F.in = args.in; F.X = args.out; F.ws = args.ws; F.ctl = (gu32*)(args.ws + WS_CTL);
    for (int u = F.tid; u < (LDS_BYTES - LDSCTL_OFF) / 4; u += NWAVES * 64) ((LAS unsigned*)(F.lds + LDSCTL_OFF))[u] = 0u;
    __syncthreads();
    const int lo = args.ph_lo, hi = args.ph_hi;
    const bool multi = (hi - lo) > 1 && lo < PH_PREP;
    XcdBarrier bar; bar.bar = (unsigned*)(F.ctl + CW_BAR); bar.x = 0; bar.st = nullptr;
    if (multi) bar = xcd_barrier_post((unsigned*)(F.ctl + CW_BAR), F.MISC + 8, F.tid == 0);
#define IN(k) (lo <= (k) && (k) < hi)
#define PIN(k) (P.in[k])
#define OPAQUE_FRAME(P) Frame P = F; asm volatile("v_mbcnt_lo_u32_b32 %0, -1, 0\n\tv_mbcnt_hi_u32_b32 %0, -1, %0" : "=v"(P.lane)); P.tid = P.wave * 64 + P.lane; \
    { int z_; asm volatile("v_mov_b32 %0, 0" : "=v"(z_)); z_ = __builtin_amdgcn_readfirstlane(z_); P.ws += z_; P.X += z_; P.in += z_; } P.ctl = (gu32*)(P.ws + WS_CTL)
#define SEAM(k) do { if (IN((k) + 1) && multi) { int l_; asm volatile("v_mbcnt_lo_u32_b32 %0, -1, 0\n\tv_mbcnt_hi_u32_b32 %0, -1, %0" : "=v"(l_)); XcdBarrier b2_ = bar; { int z_; asm volatile("v_mov_b32 %0, 0" : "=v"(z_)); b2_.bar += __builtin_amdgcn_readfirstlane(z_); } xcd_barrier(b2_, F.wave == 0 && l_ == 0); } } while (0)
    LAS unsigned char* ring = F.lds + RING_OFF;

    if (IN(0)) { OPAQUE_FRAME(P); p0_prologue(P, 0, 2 * JOBS_PER_PAIR); SEAM(0); }
#ifdef PROBE_EXTRA
    if (lo == 201 || lo == 202 || lo == 203) { OPAQUE_FRAME(P); bf16* XB = (bf16*)fact(P, FA_XB); const int pit = lo == 203 ? 1088 : 1024;
        pg8::Gemm g{XB, wt(P, 1, WO_W13), pit, pit, 1024}; pg8::StaticOrder S; S.init(TT, 5632, P.G, (int)blockIdx.x, pit, pit);
        if (lo != 202) { pg8::EpiNull E{(bf16*)fact(P, FA_H)}; pg8::gemm_phase<pg8::EpiNull, pg8::StaticOrder, true, true>(ring, g, S, E, P.wave); }
        else { pg8::EpiScaleBf16 E{(bf16*)fact(P, FA_H), 2816, (const float*)fact(P, FA_SLOT + SL_GATE), 11, 1.f}; pg8::gemm_phase<pg8::EpiScaleBf16, pg8::StaticOrder, true, true>(ring, g, S, E, P.wave); }
        return; }
#endif
#ifdef PROBE_EXTRA
    if ((lo >= 204 && lo <= 209) || lo == 230) { OPAQUE_FRAME(P); const int lp = 1; const int pit = lo == 230 ? 512 : MOE8_PITCH / 2;
        const MoeSeg sg = moe_segments(P, lp); int kz_; asm volatile("v_mov_b32 %0, 0" : "=v"(kz_)); kz_ = __builtin_amdgcn_readfirstlane(kz_);
        pg8::Gemm g{(bf16*)fact(P, FA_AS), wt(P, lp, WO_M13), pit, pit, (lo == 208 ? 256 : (lo == 209 ? 128 : 512)) + kz_, 127, 127}; pg8::MoeOrder S; S.init(sg, 28, P.G, (int)blockIdx.x, pit, pit); S.probe_same = lo >= 208 ? 0 : lo - 204;
        pg8::EpiNull E{(bf16*)fact(P, FA_MH)};
        pg8::gemm_phase<pg8::EpiNull, pg8::MoeOrder, true, true, 1, PROBE_DBG>(ring, g, S, E, P.wave); return; }
#endif
#ifdef PROBE_EXTRA
    if ((lo >= 221 && lo <= 229) || (lo >= 232 && lo <= 235)) { OPAQUE_FRAME(P); const int lp = 1; bf16* XB = (bf16*)fact(P, FA_XB);
        int kz_; asm volatile("v_mov_b32 %0, 0" : "=v"(kz_)); kz_ = __builtin_amdgcn_readfirstlane(kz_);
        pg8::EpiNull EN{(bf16*)fact(P, FA_MH)};
        if (lo == 221 || lo == 222) { pg8::Gemm g{(bf16*)fact(P, FA_CKV), wt(P, lp, WO_WKVB), CKV_LD, CKV_LD, 256 + kz_}; pg8::StaticOrder S; S.init(TT, 2048, P.G, (int)blockIdx.x, CKV_LD, CKV_LD);
            pg8::EpiKV E{fact(P, FA_K), fact(P, FA_V), (const float*)fact(P, FA_KR), ssq_arr(P, 9 + 3 * lp), ssq_arr(P, 10 + 3 * lp), PIN(10) + lp * 192, (LAS float*)(P.lds + XCH_OFF)};
            if (lo == 221) pg8::gemm_phase<pg8::EpiKV, pg8::StaticOrder, true, true>(ring, g, S, E, P.wave); else pg8::gemm_phase<pg8::EpiNull, pg8::StaticOrder, true, true, 0, PROBE_DBG>(ring, g, S, EN, P.wave); }
        else if (lo == 223 || lo == 224) { pg8::Gemm g{(bf16*)fact(P, FA_CQ), wt(P, lp, WO_WQB), CQ_LD, CQ_LD, 384 + kz_}; pg8::StaticOrder S; S.init(TT, 1536, P.G, (int)blockIdx.x, CQ_LD, CQ_LD);
            pg8::EpiRstdBf16 E{(bf16*)fact(P, FA_Q), 1536, ssq_arr(P, 8 + 3 * lp), 1.f / 384.f};
            if (lo == 223) pg8::gemm_phase<pg8::EpiRstdBf16, pg8::StaticOrder, true, true>(ring, g, S, E, P.wave); else pg8::gemm_phase<pg8::EpiNull, pg8::StaticOrder, true, true, 0, PROBE_DBG>(ring, g, S, EN, P.wave); }
        else if (lo == 228) { pg8::Gemm g{XB, wt(P, lp, WO_W13), 1024, 1024, 256 + kz_}; pg8::StaticOrder S; S.init(TT, 2048, P.G, (int)blockIdx.x, 1024, 1024); pg8::gemm_phase<pg8::EpiNull, pg8::StaticOrder, true, true, 0, PROBE_DBG>(ring, g, S, EN, P.wave); }
        else if (lo == 229) { pg8::Gemm g{XB, wt(P, lp, WO_W13), 320, 320, 256 + kz_}; pg8::StaticOrder S; S.init(TT, 2048, P.G, (int)blockIdx.x, 320, 320); pg8::gemm_phase<pg8::EpiNull, pg8::StaticOrder, true, true, 0, PROBE_DBG>(ring, g, S, EN, P.wave); }
        else if (lo == 232) { pg8::Gemm g{(bf16*)fact(P, FA_XC), wt(P, lp, WO_WG), 1024, 192, 128 + kz_}; pg8::GateOrder S{P.G, (int)blockIdx.x}; pg8::gemm_phase<pg8::EpiNull, pg8::GateOrder, true, true, 0, PROBE_DBG>(ring, g, S, EN, P.wave); }
        else if (lo == 233) { pg8::Gemm g{(bf16*)fact(P, FA_CQ), wt(P, lp, WO_WQB), 448, 448, 384 + kz_}; pg8::StaticOrder S; S.init(TT, 1536, P.G, (int)blockIdx.x, 448, 448); pg8::gemm_phase<pg8::EpiNull, pg8::StaticOrder, true, true, 0, PROBE_DBG>(ring, g, S, EN, P.wave); }
        else if (lo == 225) { pg8::Gemm g{XB, wt(P, lp, WO_LIN), 1024, 1024, 1024 + kz_}; pg8::StaticOrder S; S.init(TT, 2048, P.G, (int)blockIdx.x, 1024, 1024); pg8::gemm_phase<pg8::EpiNull, pg8::StaticOrder, true, true, 0, PROBE_DBG>(ring, g, S, EN, P.wave); }
        else if (lo == 226) { pg8::Gemm g{(bf16*)fact(P, FA_XC), wt(P, lp, WO_WG), 1024, WG_LD, 128 + kz_}; pg8::GateOrder S{P.G, (int)blockIdx.x}; pg8::gemm_phase<pg8::EpiNull, pg8::GateOrder, true, true, 0, PROBE_DBG>(ring, g, S, EN, P.wave); }
        else { pg8::Gemm g{XB, wt(P, lp, WO_WINA), 1024, 1024, 1024 + kz_}; pg8::StaticOrder S; S.init(TT, 768, P.G, (int)blockIdx.x, 1024, 1024); pg8::gemm_phase<pg8::EpiNull, pg8::StaticOrder, true, true, 0, PROBE_DBG>(ring, g, S, EN, P.wave); }
        return; }
#endif
#ifdef PROBE_EXTRA
    if (lo == 244 || lo == 245) { OPAQUE_FRAME(P); bf16* XB = (bf16*)fact(P, FA_XB);
        pg8::Gemm g{XB, wt(P, 0, WO_W13), 1024, 1024, 1024}; pg8::StaticOrder S; S.init(TT, 5632, P.G, (int)blockIdx.x, 1024, 1024);
        pg8::EpiSwiGLU E{(bf16*)fact(P, FA_H), 2816, lo == 244 ? ssq_arr(P, 1) : nullptr, 22, 0, 1.f};
        pg8::gemm_phase<pg8::EpiSwiGLU, pg8::StaticOrder, true, true>(ring, g, S, E, P.wave); return; }
#endif
#ifdef PROBE_EXTRA
    if (lo == 243) { if (blockIdx.x == 0 && F.tid < 8) F.ctl[CW_MOE + 64 + 16 + F.tid] = 0u; return; }
    if (lo == 299) return;
#endif
    if (lo == 200) { OPAQUE_FRAME(P); p0_prologue(P, 0, 2 * JOBS_PER_PAIR, false); return; }
    if (lo >= PH_PREP) { OPAQUE_FRAME(P); prep_rows(P, P.X, nullptr, ssq_arr(P, lo - PH_PREP)); return; }

    for (int lp = 0; lp < 2; ++lp) {
        const int pb = 1 + lp * PH_PER_PAIR;
        if (IN(pb + PH_M1)) { OPAQUE_FRAME(P); bf16* XB = (bf16*)fact(P, FA_XB);
            pg8::Gemm g{XB, wt(P, lp, WO_WINA), 1024, 1024, 1024}; pg8::StaticOrder S; S.init(TT, 768, P.G, (int)blockIdx.x, 1024, 1024);
            pg8::EpiMlaIn E{(bf16*)fact(P, FA_CQ), (bf16*)fact(P, FA_CKV), (float*)fact(P, FA_KR), ssq_arr(P, 4 * lp), ssq_arr(P, 8 + 3 * lp), ssq_arr(P, 9 + 3 * lp), ssq_arr(P, 10 + 3 * lp), PIN(10) + lp * 192, (const float*)fact(P, FA_ROPE)};
            pg8::gemm_phase<pg8::EpiMlaIn, pg8::StaticOrder, true, true>(ring, g, S, E, P.wave);
            SEAM(pb + PH_M1);
        }
        if (IN(pb + PH_M2)) {
            { OPAQUE_FRAME(P);
              int kz_; asm volatile("v_mov_b32 %0, 0" : "=v"(kz_)); kz_ = __builtin_amdgcn_readfirstlane(kz_);
              pg8::Gemm g{(bf16*)fact(P, FA_CKV), wt(P, lp, WO_WKVB), CKV_LD, CKV_LD, 256 + kz_}; pg8::StaticOrder S; S.init(TT, 2048, P.G, (int)blockIdx.x, CKV_LD, CKV_LD);
              pg8::EpiKV E{fact(P, FA_K), fact(P, FA_V), (const float*)fact(P, FA_KR), ssq_arr(P, 9 + 3 * lp), ssq_arr(P, 10 + 3 * lp), PIN(10) + lp * 192, (LAS float*)(P.lds + XCH_OFF)};
              pg8::gemm_phase<pg8::EpiKV, pg8::StaticOrder, true, true>(ring, g, S, E, P.wave); }
            { OPAQUE_FRAME(P);
              int kz_; asm volatile("v_mov_b32 %0, 0" : "=v"(kz_)); kz_ = __builtin_amdgcn_readfirstlane(kz_);
              pg8::Gemm g{(bf16*)fact(P, FA_CQ), wt(P, lp, WO_WQB), CQ_LD, CQ_LD, 384 + kz_}; pg8::StaticOrder S; S.init(TT, 1536, P.G, (int)blockIdx.x, CQ_LD, CQ_LD);
              pg8::EpiRstdBf16 E{(bf16*)fact(P, FA_Q), 1536, ssq_arr(P, 8 + 3 * lp), 1.f / 384.f};
              pg8::gemm_phase<pg8::EpiRstdBf16, pg8::StaticOrder, true, true>(ring, g, S, E, P.wave); }
            SEAM(pb + PH_M2);
        }
        if (IN(pb + PH_ATT)) { OPAQUE_FRAME(P); att::attn_phase(P, lp); SEAM(pb + PH_ATT); }
        if (IN(pb + PH_WO)) { OPAQUE_FRAME(P); bf16* XB = (bf16*)fact(P, FA_XB);
            pg8::Gemm g{(bf16*)fact(P, FA_O), wt(P, lp, WO_WO), 1024, 1024, 1024}; pg8::StaticOrder S; S.init(TT, 1024, P.G, (int)blockIdx.x, 1024, 1024);
#if FFN_F8
            pg8::EpiResid E{P.X, XB, ssq_arr(P, 4 * lp + 1), nullptr, ffn_fu8(lp) ? fact(P, FA_XB8) : nullptr, 1.f};
#else
            pg8::EpiResid E{P.X, XB, ssq_arr(P, 4 * lp + 1), nullptr};
#endif
            pg8::gemm_phase<pg8::EpiResid, pg8::StaticOrder, true, true>(ring, g, S, E, P.wave);
            SEAM(pb + PH_WO);
        }
        if (IN(pb + PH_FU)) { OPAQUE_FRAME(P); bf16* XB = (bf16*)fact(P, FA_XB); pg8::StaticOrder S;
#if FFN_F8
            if (ffn_fu8(lp)) {
            int kz_; asm volatile("v_mov_b32 %0, 0" : "=v"(kz_)); kz_ = __builtin_amdgcn_readfirstlane(kz_);
            pg8::Gemm g{(bf16*)fact(P, FA_XB8), wt(P, lp, WO_W13), 512, 512, 512 + kz_, 127, 127}; S.init(TT, 5632, P.G, (int)blockIdx.x, 512, 512);
            pg8::EpiSwiGLU E{(bf16*)fact(P, FA_H), 2816, ssq_arr(P, 4 * lp + 1), 22, ffn_fd8(lp) ? 1 : 0, 1.f / 64.f};
            pg8::gemm_phase<pg8::EpiSwiGLU, pg8::StaticOrder, true, true, 1>(ring, g, S, E, P.wave);
            } else
#endif
            {
            pg8::Gemm g{XB, wt(P, lp, WO_W13), 1024, 1024, 1024}; S.init(TT, 5632, P.G, (int)blockIdx.x, 1024, 1024);
            pg8::EpiSwiGLU E{(bf16*)fact(P, FA_H), 2816, ssq_arr(P, 4 * lp + 1), 22, ffn_fd8(lp) ? 1 : 0, 1.f};
            pg8::gemm_phase<pg8::EpiSwiGLU, pg8::StaticOrder, true, true>(ring, g, S, E, P.wave);
            }
            if (TAIL_SLOTS) { const int fi = S.nwg % P.G; if (lp == 0) tail_convert(P, 56, 59, fi ? fi : P.G); }
            SEAM(pb + PH_FU);
        }
        if (IN(pb + PH_FD)) { OPAQUE_FRAME(P); bf16* XB = (bf16*)fact(P, FA_XB);
#if FFN_F8
            if (ffn_fd8(lp)) {
            int kz_; asm volatile("v_mov_b32 %0, 0" : "=v"(kz_)); kz_ = __builtin_amdgcn_readfirstlane(kz_);
            pg8::Gemm g{(bf16*)fact(P, FA_H), wt(P, lp, WO_W2), 1408, 1408, 1408 + kz_, 127, 127}; pg8::StaticOrder S; S.init(TT, 1024, P.G, (int)blockIdx.x, 1408, 1408);
            pg8::EpiResid E{P.X, XB, ssq_arr(P, 4 * lp + 2), nullptr, nullptr, 1.f / 64.f};
            pg8::gemm_phase<pg8::EpiResid, pg8::StaticOrder, true, true, 1>(ring, g, S, E, P.wave);
            } else {
            pg8::Gemm g{(bf16*)fact(P, FA_H), wt(P, lp, WO_W2), 2816, 2816, 2816}; pg8::StaticOrder S; S.init(TT, 1024, P.G, (int)blockIdx.x, 2816, 2816);
            pg8::EpiResid E{P.X, XB, ssq_arr(P, 4 * lp + 2), nullptr, nullptr, 1.f};
            pg8::gemm_phase<pg8::EpiResid, pg8::StaticOrder, true, true>(ring, g, S, E, P.wave);
            }
#else
            pg8::Gemm g{(bf16*)fact(P, FA_H), wt(P, lp, WO_W2), 2816, 2816, 2816}; pg8::StaticOrder S; S.init(TT, 1024, P.G, (int)blockIdx.x, 2816, 2816);
            pg8::EpiResid E{P.X, XB, ssq_arr(P, 4 * lp + 2), nullptr};
            pg8::gemm_phase<pg8::EpiResid, pg8::StaticOrder, true, true>(ring, g, S, E, P.wave);
#endif
            SEAM(pb + PH_FD);
        }
        if (IN(pb + PH_L1)) { OPAQUE_FRAME(P); bf16* XB = (bf16*)fact(P, FA_XB);
            pg8::Gemm g{XB, wt(P, lp, WO_LIN), 1024, 1024, 1024}; pg8::StaticOrder S; S.init(TT, 2048, P.G, (int)blockIdx.x, 1024, 1024);
            pg8::EpiLruIn E{(bf16*)fact(P, FA_G), (bf16*)fact(P, FA_XBR), ssq_arr(P, 4 * lp + 2), PIN(13) + lp * 2048};
            pg8::gemm_phase<pg8::EpiLruIn, pg8::StaticOrder, true, true>(ring, g, S, E, P.wave);
            SEAM(pb + PH_L1);
        }
        if (IN(pb + PH_L2)) { OPAQUE_FRAME(P); conv_phase(P, lp); SEAM(pb + PH_L2); }
        if (IN(pb + PH_L3)) { OPAQUE_FRAME(P); bf16* XB = (bf16*)fact(P, FA_XB);
            int kz_; asm volatile("v_mov_b32 %0, 0" : "=v"(kz_)); kz_ = __builtin_amdgcn_readfirstlane(kz_);
            pg8::Gemm g{(bf16*)fact(P, FA_XC), wt(P, lp, WO_WG), 1024, WG_LD, 128 + kz_}; pg8::GateOrder S{P.G, (int)blockIdx.x};
            pg8::EpiGates E{(bf16*)fact(P, FA_LA), (bf16*)fact(P, FA_U), PIN(17) + lp * 1024, PIN(19) + lp * 1024};
            pg8::gemm_phase<pg8::EpiGates, pg8::GateOrder, true, true>(ring, g, S, E, P.wave);
            SEAM(pb + PH_L3);
        }
        if (IN(pb + PH_L4)) { OPAQUE_FRAME(P); scan_phase(P, lp); SEAM(pb + PH_L4); }
        if (IN(pb + PH_L5)) { OPAQUE_FRAME(P); bf16* XB = (bf16*)fact(P, FA_XB);
            pg8::Gemm g{(bf16*)fact(P, FA_YG), wt(P, lp, WO_WOUT), 1024, 1024, 1024}; pg8::StaticOrder S; S.init(TT, 1024, P.G, (int)blockIdx.x, 1024, 1024);
            #if FFN_F8
            pg8::EpiResid E{P.X, XB, nullptr, PIN(22) + lp * 1024, nullptr, 1.f};
#else
            pg8::EpiResid E{P.X, XB, nullptr, PIN(22) + lp * 1024};
#endif
            pg8::gemm_phase<pg8::EpiResid, pg8::StaticOrder, true, true>(ring, g, S, E, P.wave);
            SEAM(pb + PH_L5);
        }
        if (IN(pb + PH_R1)) { OPAQUE_FRAME(P); r1_phase(P, lp); SEAM(pb + PH_R1); }
        if (IN(pb + PH_R2)) { OPAQUE_FRAME(P); r2_phase(P, lp); SEAM(pb + PH_R2); }
        if (IN(pb + PH_MU) && lp != FP8_LP) { OPAQUE_FRAME(P);
            const MoeSeg sg = moe_segments(P, lp);
#if FP8_ALL
            int kz_; asm volatile("v_mov_b32 %0, 0" : "=v"(kz_)); kz_ = __builtin_amdgcn_readfirstlane(kz_);
            pg8::Gemm g{(bf16*)fact(P, FA_AS), wt(P, lp, WO_M13), MOE8_PITCH / 2, MOE8_PITCH / 2, 512 + kz_, 127, 127}; pg8::MoeOrder S; S.init(sg, 28, P.G, (int)blockIdx.x, MOE8_PITCH / 2, MOE8_PITCH / 2);
            pg8::EpiSwiGLU E{(bf16*)fact(P, FA_MH), 3584, nullptr, 28, 1, 1.f / 64.f};
            pg8::gemm_phase<pg8::EpiSwiGLU, pg8::MoeOrder, true, true, 1>(ring, g, S, E, P.wave);
            if (TAIL_SLOTS && lp == 0) { const int nl = S.U % P.G; tail_convert(P, 54, 55, nl ? nl : P.G); }
#else
            pg8::Gemm g{(bf16*)fact(P, FA_AS), wt(P, lp, WO_M13), 1024, 1024, 1024}; pg8::MoeOrder S; S.init(sg, 28, P.G, (int)blockIdx.x, 1024, 1024);
            pg8::EpiSwiGLU E{(bf16*)fact(P, FA_MH), 3584, (const fx64*)fact(P, FA_SLOT + SL_SSQ), 28, 0, 1.f};
            pg8::gemm_phase<pg8::EpiSwiGLU, pg8::MoeOrder, true, true>(ring, g, S, E, P.wave);
#endif
            SEAM(pb + PH_MU);
        }
        if (IN(pb + PH_MD) && lp != FP8_LP) { OPAQUE_FRAME(P);
            const MoeSeg sg = moe_segments(P, lp);
#if FP8_ALL
            int kz_; asm volatile("v_mov_b32 %0, 0" : "=v"(kz_)); kz_ = __builtin_amdgcn_readfirstlane(kz_);
            pg8::EpiScaleBf16 E{(bf16*)fact(P, FA_Y), 1024, nullptr, 4, 1.f / 128.f};
            pg8::Gemm g{(bf16*)fact(P, FA_MH), wt(P, lp, WO_M2), 1792, 1792, 1792 + kz_, 127, 127}; pg8::MoeOrder S; S.init(sg, 4, P.G, (int)blockIdx.x, 1792, 1792);
            pg8::gemm_phase<pg8::EpiScaleBf16, pg8::MoeOrder, true, true, 1>(ring, g, S, E, P.wave);
            if (TAIL_SLOTS && lp == 0) tail_convert(P, 48, 54, S.U > 2 * P.G ? S.U - 2 * P.G : P.G);
#else
            pg8::EpiScaleBf16 E{(bf16*)fact(P, FA_Y), 1024, nullptr, 4, 1.f};
            pg8::Gemm g{(bf16*)fact(P, FA_MH), wt(P, lp, WO_M2), 3584, 3584, 3584}; pg8::MoeOrder S; S.init(sg, 4, P.G, (int)blockIdx.x, 3584, 3584);
            pg8::gemm_phase<pg8::EpiScaleBf16, pg8::MoeOrder, true, true>(ring, g, S, E, P.wave);
#endif
            SEAM(pb + PH_MD);
        }
        if (IN(pb + PH_CB) && lp != FP8_LP) { OPAQUE_FRAME(P); cb_phase(P, lp); SEAM(pb + PH_CB); }
    }
    if (FP8_LP >= 0) { const int lp = FP8_LP, pb = 1 + lp * PH_PER_PAIR;
        if (IN(pb + PH_MU)) { OPAQUE_FRAME(P);
            const MoeSeg sg = moe_segments(P, lp);
            int kz_; asm volatile("v_mov_b32 %0, 0" : "=v"(kz_)); kz_ = __builtin_amdgcn_readfirstlane(kz_);
            pg8::Gemm g{(bf16*)fact(P, FA_AS), wt(P, lp, WO_M13), MOE8_PITCH / 2, MOE8_PITCH / 2, 512 + kz_, 127, 127 - 6}; pg8::MoeOrder S; S.init(sg, 28, P.G, (int)blockIdx.x, MOE8_PITCH / 2, MOE8_PITCH / 2);
            pg8::EpiSwiGLU E{(bf16*)fact(P, FA_MH), 3584, (const fx64*)fact(P, FA_SLOT + SL_SSQ), 28, 1, 1.f / 64.f};
            pg8::gemm_phase<pg8::EpiSwiGLU, pg8::MoeOrder, true, true, 1>(ring, g, S, E, P.wave);
            SEAM(pb + PH_MU);
        }
        if (IN(pb + PH_MD)) { OPAQUE_FRAME(P);
            const MoeSeg sg = moe_segments(P, lp);
            int kz_; asm volatile("v_mov_b32 %0, 0" : "=v"(kz_)); kz_ = __builtin_amdgcn_readfirstlane(kz_);
            pg8::EpiScaleBf16 E{(bf16*)fact(P, FA_Y), 1024, nullptr, 4, 1.f / 128.f};
            pg8::Gemm g{(bf16*)fact(P, FA_MH), wt(P, lp, WO_M2), 1792, 1792, 1792 + kz_, 127, 127 - 7}; pg8::MoeOrder S; S.init(sg, 4, P.G, (int)blockIdx.x, 1792, 1792);
            pg8::gemm_phase<pg8::EpiScaleBf16, pg8::MoeOrder, true, true, 1>(ring, g, S, E, P.wave);
            SEAM(pb + PH_MD);
        }
        if (IN(pb + PH_CB)) { OPAQUE_FRAME(P); cb_phase(P, lp); SEAM(pb + PH_CB); }
    }
#undef IN
#undef SEAM
}

static void launch_mega(hipStream_t stream, const Args& a0, int grid, int lo, int hi) {
    Args a = a0; a.ph_lo = lo; a.ph_hi = hi;
    hipLaunchKernelGGL(mega, dim3(grid), dim3(NWAVES * 64), LDS_BYTES, stream, a);
}
#if ONE_LAUNCH
extern "C" void kernel_launch(void* const* d_in, const int* in_sizes, int n_in, void* d_out, int out_size, void* d_ws, size_t ws_size, hipStream_t stream) {
    if (n_in != 31 || out_size != TT * 1024 || ws_size < 896 * MiB) { fprintf(stderr, "kernel_launch: bad shapes n_in %d out %d ws %zu\n", n_in, out_size, ws_size); return; }
    static int grid = 0;
    if (!grid) {
        if (hipFuncSetAttribute((const void*)mega, hipFuncAttributeMaxDynamicSharedMemorySize, LDS_BYTES) != hipSuccess) { fprintf(stderr, "kernel_launch: hipFuncSetAttribute failed\n"); grid = -1; return; }
        int dev = 0, cus = 0, per_cu = 0; (void)hipGetDevice(&dev); (void)hipDeviceGetAttribute(&cus, hipDeviceAttributeMultiprocessorCount, dev);
        if (hipOccupancyMaxActiveBlocksPerMultiprocessor(&per_cu, (const void*)mega, NWAVES * 64, LDS_BYTES) != hipSuccess || per_cu < 1) fprintf(stderr, "kernel_launch: occupancy query reports %d blocks per CU\n", per_cu);
        (void)hipGetLastError();
        grid = cus > 0 ? cus : 256;
    }
    if (grid < 0) return;
    unsigned char* ws = (unsigned char*)d_ws;
    (void)hipMemsetAsync(ws + WS_CTL, 0, CTL_ZERO_BYTES, stream);
    Args a; memset(&a, 0, sizeof(a)); for (int i = 0; i < 31; ++i) a.in[i] = (const float*)d_in[i]; a.out = (float*)d_out; a.ws = ws;
    launch_mega(stream, a, grid, 0, PH_END);
#ifdef PROBE_EXTRA
    { const int extra[] = {PROBE_EXTRA}; for (int e : extra) launch_mega(stream, a, grid, e, e + 1); }
#endif
}
#else
extern "C" void kernel_launch(void* const* d_in, const int* in_sizes, int n_in, void* d_out, int out_size, void* d_ws, size_t ws_size, hipStream_t stream) {
    if (n_in != 31 || out_size != orc::T * 1024 || ws_size < 896 * MiB) { fprintf(stderr, "kernel_launch: bad shapes n_in %d out %d ws %zu\n", n_in, out_size, ws_size); return; }
    static int grid = 0;
    if (!grid) {
        hipFuncSetAttribute((const void*)orc::attn, hipFuncAttributeMaxDynamicSharedMemorySize, orc::ATT_LDS);
        hipFuncSetAttribute((const void*)mega, hipFuncAttributeMaxDynamicSharedMemorySize, LDS_BYTES);
        int dev = 0, cus = 0; hipGetDevice(&dev); hipDeviceGetAttribute(&cus, hipDeviceAttributeMultiprocessorCount, dev); grid = cus > 0 ? cus : 256;
    }
    const float* const* in = (const float* const*)d_in; const int* pos = (const int*)d_in[1];
    unsigned char* ws = (unsigned char*)d_ws; float* X = (float*)d_out;
    orc::Bufs b; unsigned char* act = ws + WS_FACT;
    b.XN = (float*)act; b.HC = (float*)(act + 64 * MiB); b.Kf = (float*)(act + 112 * MiB); b.Q = (float*)(act + 208 * MiB); b.KV = (float*)(act + 304 * MiB); b.H = (float*)(act + 208 * MiB);
    unsigned char* sm = ws + 5 * MiB; b.te = (int*)sm; b.tw = (float*)(sm + 128 * 1024); b.list = (int*)(sm + 256 * 1024); b.gate = (float*)(sm + 768 * 1024); b.cnt = (int*)(sm + 1280 * 1024);
    hipMemsetAsync(ws + WS_CTL, 0, CTL_ZERO_BYTES, stream);
    Args a; memset(&a, 0, sizeof(a)); for (int i = 0; i < 31; ++i) a.in[i] = (const float*)d_in[i]; a.out = X; a.ws = ws;
    launch_mega(stream, a, grid, 0, 1);
    for (int i = 0; i < 4; ++i) {
        const int j = i / 2, pb = 1 + j * PH_PER_PAIR;
        if (i % 2 == 0) {
#if FAST_MLA
            launch_mega(stream, a, grid, PH_PREP + 4 * j, PH_PREP + 4 * j + 1);
            for (int p = PH_M1; p <= PH_WO; ++p) launch_mega(stream, a, grid, pb + p, pb + p + 1);
#else
            orc::mla(stream, X, b, pos, in[2] + i * 1024, in[4] + (size_t)j * 1024 * 704, in[5] + j * 384, in[6] + (size_t)j * 384 * 1536, in[7] + j * 256, in[8] + (size_t)j * 256 * 2048, in[9] + j * 192, in[10] + j * 192, in[11] + (size_t)j * 1024 * 1024);
#endif
#if FAST_FFN
#if !FAST_MLA
            launch_mega(stream, a, grid, PH_PREP + 4 * j + 1, PH_PREP + 4 * j + 2);
#endif
            launch_mega(stream, a, grid, pb + PH_FU, pb + PH_FU + 1);
            launch_mega(stream, a, grid, pb + PH_FD, pb + PH_FD + 1);
#else
            orc::ffn(stream, X, b, in[3] + i * 1024, in[23] + (size_t)j * 1024 * 2816, in[24] + (size_t)j * 1024 * 2816, in[25] + (size_t)j * 2816 * 1024);
#endif
        } else {
#if FAST_LRU
            launch_mega(stream, a, grid, PH_PREP + 4 * j + 2, PH_PREP + 4 * j + 3);
            for (int p = PH_L1; p <= PH_L5; ++p) launch_mega(stream, a, grid, pb + p, pb + p + 1);
#else
            orc::lru(stream, X, b, in[2] + i * 1024, in[12] + (size_t)j * 1024 * 2048, in[13] + j * 2048, in[14] + j * 4096, in[15] + j * 1024, in[16] + (size_t)j * 8 * 128 * 128, in[17] + j * 1024,
                     in[18] + (size_t)j * 8 * 128 * 128, in[19] + j * 1024, in[20] + j * 1024, in[21] + (size_t)j * 1024 * 1024, in[22] + j * 1024);
#endif
#if FAST_MOE
            launch_mega(stream, a, grid, PH_PREP + 4 * j + 3, PH_PREP + 4 * j + 4);
            for (int p = PH_R1; p <= PH_CB; ++p) launch_mega(stream, a, grid, pb + p, pb + p + 1);
#else
            orc::moe(stream, X, b, in[3] + i * 1024, in[26] + j * 1024 * 8, in[27] + j * 8, in[28] + (size_t)j * 8 * 1024 * 3584, in[29] + (size_t)j * 8 * 1024 * 3584, in[30] + (size_t)j * 8 * 3584 * 1024);
#endif
        }
    }
}
#endif
```

```cpp
#include <hip/hip_runtime.h>
#include <cstdio>
#include <cstdint>
#include <cstring>
constexpr size_t MiB = 1u << 20;
#define ONE_LAUNCH 1
#define FP8_ALL 1
#define FFN_F8 3
#define FFN_F8_LPS 2
#define LRU_F8 3
constexpr int NWAVES = 8;
constexpr int TT = 16384, DM = 1024, SEQL = 2048;
constexpr float NEPS = 1e-6f;
#ifndef FP8_LAST
#define FP8_LAST 1
#endif
#ifndef FP8_ALL
#define FP8_ALL 0
#endif
constexpr int FP8_LP = (FP8_LAST && !FP8_ALL) ? 1 : -1;
#ifndef FFN_F8
#define FFN_F8 0
#endif
#ifndef FFN_F8_LPS
#define FFN_F8_LPS 2
#endif
#ifndef LRU_F8
#define LRU_F8 0
#endif
#ifndef MOE_KSPLIT
#define MOE_KSPLIT 1
#endif
constexpr int KSPLIT_N = 7;
__host__ __device__ constexpr bool moe_ksplit(int lp) { return MOE_KSPLIT != 0 && FP8_ALL != 0 && lp == 1; }
__host__ __device__ constexpr bool lru_out8(int lp) { return (LRU_F8 & 2) != 0 && ((FFN_F8_LPS >> lp) & 1) != 0; }
__host__ __device__ constexpr bool lru_in8(int lp) { return (LRU_F8 & 1) != 0 && ((FFN_F8_LPS >> lp) & 1) != 0; }
__host__ __device__ constexpr bool ffn_fu8(int lp) { return (FFN_F8 & 1) != 0 && ((FFN_F8_LPS >> lp) & 1) != 0; }
__host__ __device__ constexpr bool ffn_fd8(int lp) { return (FFN_F8 & 2) != 0 && ((FFN_F8_LPS >> lp) & 1) != 0; }
constexpr size_t FA_XB8 = 448 * MiB;
__host__ __device__ constexpr bool moe_f8(int lp) { return FP8_ALL || lp == FP8_LP; }
constexpr size_t WS_CTL = 0, CTL_ZERO_BYTES = 3 * MiB;
constexpr size_t WS_WT = 8 * MiB;
constexpr size_t WS_FACT = 404 * MiB;
constexpr int CW_TMO = 0, CW_CODE = 1, CW_BAR = 4096;
constexpr int CW_MOE = 8192;
constexpr int CW_SSQ = 262144;
static_assert((size_t)CW_SSQ * 4 + (size_t)14 * TT * 8 <= CTL_ZERO_BYTES, "CTL");
constexpr size_t WT_PAIR = 198 * MiB;
constexpr int CKV_LD = 320;
constexpr int CQ_LD = 448;
constexpr int WG_LD = 192;
constexpr int MOE8_PITCH = 1152;
constexpr size_t WO_WINA = 0, WO_WQB = WO_WINA + 768 * 1024 * 2, WO_WKVB = WO_WQB + 1536 * CQ_LD * 2, WO_WO = WO_WKVB + 2048 * CKV_LD * 2, WO_W13 = WO_WO + 1024 * 1024 * 2, WO_W2 = WO_W13 + 5632 * 1024 * 2,
                 WO_LIN = WO_W2 + 1024 * 2816 * 2, WO_WG = WO_LIN + 2048 * 1024 * 2, WO_WOUT = WO_WG + 8 * 256 * WG_LD * 2, WO_M13 = WO_WOUT + 1024 * 1024 * 2, WO_M2 = WO_M13 + (size_t)8 * 7168 * 1024 * 2,
                 WO_END = WO_M2 + (size_t)8 * 1024 * 3584 * 2;
static_assert(WO_END <= WT_PAIR && WS_WT + 2 * WT_PAIR <= WS_FACT, "weights map");
constexpr size_t FA_XB = 0;
constexpr size_t FA_H = 32 * MiB;
constexpr size_t FA_AS = 32 * MiB, FA_MH = 100 * MiB, FA_Y = 338 * MiB, FA_SLOT = 436 * MiB;
constexpr size_t FA_CQ = 32 * MiB, FA_CKV = 216 * MiB  , FA_KR = 52 * MiB, FA_Q = 56 * MiB, FA_K = 104 * MiB, FA_V = 152 * MiB, FA_O = 184 * MiB;
constexpr size_t FA_G = 32 * MiB, FA_XBR = 64 * MiB, FA_XC = 96 * MiB, FA_LA = 128 * MiB, FA_U = 160 * MiB, FA_YG = 192 * MiB;
constexpr size_t FA_ROPE = 440 * MiB;
constexpr size_t FA_RB = 446 * MiB;
constexpr size_t FA_COEF = 444 * MiB;
constexpr int RING_OFF = 0, RING_BYTES = 131072, XCH_OFF = RING_BYTES, XCH_BYTES = 8192, LDSCTL_OFF = XCH_OFF + XCH_BYTES, MISC_OFF = LDSCTL_OFF + 320, STAT_OFF = LDSCTL_OFF + 1024  , LDS_BYTES = 153600;
static_assert(MISC_OFF + 128 <= STAT_OFF && STAT_OFF + 12288 <= LDS_BYTES, "LDS map");

#define GAS __attribute__((address_space(1)))
#define LAS __attribute__((address_space(3)))
typedef unsigned short bf16;
typedef unsigned v4u __attribute__((ext_vector_type(4)));
typedef unsigned v2u __attribute__((ext_vector_type(2)));
typedef float f32x4 __attribute__((ext_vector_type(4)));
typedef float f32x2 __attribute__((ext_vector_type(2)));
typedef short bf16x8 __attribute__((ext_vector_type(8)));
typedef GAS unsigned gu32;
#define RLX_AGENT __ATOMIC_RELAXED, __HIP_MEMORY_SCOPE_AGENT
#define LDS_WAIT() asm volatile("s_waitcnt lgkmcnt(0)" ::: "memory")
#define VM_WAIT() asm volatile("s_waitcnt vmcnt(0)" ::: "memory")
__device__ __forceinline__ unsigned f2bf(float f) { unsigned u = __builtin_bit_cast(unsigned, f); return (u + 0x7fffu + ((u >> 16) & 1u)) >> 16; }
__device__ __forceinline__ unsigned pk2(float lo, float hi) { unsigned r; asm volatile("v_cvt_pk_bf16_f32 %0, %1, %2" : "=v"(r) : "v"(lo), "v"(hi)); return r; }
typedef __bf16 bf16v2_t __attribute__((ext_vector_type(2)));
__device__ __forceinline__ unsigned pk2c(float lo, float hi) { const f32x2 v = {lo, hi}; return __builtin_bit_cast(unsigned, __builtin_convertvector(v, bf16v2_t)); }
__device__ __forceinline__ float bflo(unsigned w) { return __builtin_bit_cast(float, w << 16); }
__device__ __forceinline__ float bfhi(unsigned w) { return __builtin_bit_cast(float, w & 0xffff0000u); }
__device__ __forceinline__ float fast_rcp(float x) { return __builtin_amdgcn_rcpf(x); }
__device__ __forceinline__ float fast_exp(float x) { return __builtin_amdgcn_exp2f(x * 1.4426950408889634f); }
__device__ __forceinline__ float silu_f(float x) { return x * fast_rcp(1.f + fast_exp(-x)); }
__device__ __forceinline__ float sigm_f(float x) { return fast_rcp(1.f + fast_exp(-x)); }
__device__ __forceinline__ float rstd_of(float ssq, float invn) { return __builtin_amdgcn_rsqf(ssq * invn + NEPS); }
typedef unsigned long long fx64;
__device__ __forceinline__ fx64 fx_of(float s) { return (fx64)(s * 268435456.f); }
__device__ __forceinline__ float fx_to(fx64 v) { return (float)v * 3.7252902984619140625e-9f; }
__device__ __forceinline__ void fx_add(fx64* p, float s) { __hip_atomic_fetch_add(p, fx_of(s), __ATOMIC_RELAXED, __HIP_MEMORY_SCOPE_AGENT); }
__device__ __forceinline__ float xshfl(float v, int mask, int lane) { return __builtin_bit_cast(float, __builtin_amdgcn_ds_bpermute((lane ^ mask) << 2, __builtin_bit_cast(int, v))); }
__device__ __forceinline__ int ishfl(int v, int src_lane) { return __builtin_amdgcn_ds_bpermute(src_lane << 2, v); }
__device__ __forceinline__ float wave_sum(float v, int lane) {
#pragma unroll
    for (int o = 1; o < 64; o <<= 1) v += xshfl(v, o, lane);
    return v;
}
namespace pg8 {
#define PG8_LAS __attribute__((address_space(3)))
typedef unsigned short bf16_t;
typedef short bf16x8 __attribute__((ext_vector_type(8)));
typedef float f32x4 __attribute__((ext_vector_type(4)));
typedef unsigned u32x4 __attribute__((ext_vector_type(4)));
constexpr int STAT_TAB = 131072 + 8192 + 1024;
constexpr int BM = 256, BK = 64, HALF = 128, HTB = HALF * BK * 2  , STAGE_BYTES = 8 * HTB, NXCD = 8, WGM = 8;

__host__ __device__ __forceinline__ int lds_byte(int r, int c) { const int st = (r >> 4) * 2 + (c >> 5), rr = r & 15, cc = c & 31, ob = rr * 64 + cc * 2; return st * 1024 + (ob ^ (((ob >> 9) & 1) << 5)); }
__host__ __device__ __forceinline__ void stage_rc(int b, int& R, int& C) { const int st = b / 1024, sb = b % 1024, swz = sb ^ (((sb >> 9) & 1) << 5); R = (st >> 1) * 16 + swz / 64; C = (st & 1) * 32 + (swz % 64) / 2; }
__host__ __device__ __forceinline__ int perm32(int rho) { const int n = rho >> 4, i = rho & 15; return 8 * (i >> 2) + 4 * n + (i & 3); }

struct Unit { int pm, pn; long aoff, boff; };
struct Gemm { const bf16_t* A; const bf16_t* Bt; int lda, ldb, K; int sa, sb; };

struct StaticOrder {
    int nM, nN, nwg, G, c; long astep, bstep;
    __host__ __device__ void init(int M, int N, int G_, int c_, int lda, int ldb) { nM = M / BM; nN = N / BM; nwg = nM * nN; G = G_; c = c_; astep = (long)BM * lda * 2; bstep = (long)BM * ldb * 2; }
    __host__ __device__ bool next(int i, Unit& u) const {
        const int L = i * G + c; if (L >= nwg) return false;
        int wgid = (int)L; { const int q = nwg / NXCD, r = nwg % NXCD, xcd = wgid % NXCD, off = wgid / NXCD; wgid = (xcd < r ? xcd * (q + 1) : r * (q + 1) + (xcd - r) * q) + off; }
        const int nig = WGM * nN, gid = wgid / nig, fm = gid * WGM, gsz = (nM - fm) < WGM ? (nM - fm) : WGM;
        u.pm = fm + ((wgid % nig) % gsz); u.pn = (wgid % nig) / gsz; u.aoff = u.pm * astep; u.boff = u.pn * bstep; return true;
    }
    __device__ __forceinline__ void a_ready(const Unit&) const {}
    __device__ __forceinline__ void done(const Unit&) const {}
};

typedef int v8i_t __attribute__((ext_vector_type(8)));
typedef short bf16x16 __attribute__((ext_vector_type(16)));
typedef int v4i_t __attribute__((ext_vector_type(4)));
template <class Epi, class Sched, bool ALIGN_EPI = false, bool SP2 = false, int KIND = 0, int DBG = 0>
__device__ __forceinline__ void gemm_phase(PG8_LAS unsigned char* lds, const Gemm g, const Sched& S, const Epi& E, const int wave_s  ) {
    int tid_; asm volatile("v_mbcnt_lo_u32_b32 %0, -1, 0\n\tv_mbcnt_hi_u32_b32 %0, -1, %0" : "=v"(tid_)); tid_ += wave_s * 64;
    const int tid = tid_, wid = __builtin_amdgcn_readfirstlane(tid >> 6), lane = tid & 63, wr = wid >> 2, wc = wid & 3, fr = lane & 15, fq = lane >> 4;
    const int K = g.K, nt = K / BK;
    unsigned voffA[2], voffB[2];
#pragma unroll
    for (int i = 0; i < 2; ++i) { int R, C; stage_rc(tid * 16 + i * 8192, R, C); const int Rb = Epi::PERM ? ((R & ~31) + perm32(R & 31)) : R;
        voffA[i] = (unsigned)(R * g.lda + C) * 2u; voffB[i] = (unsigned)(Rb * g.ldb + C) * 2u; }
    const size_t kstep = (size_t)(BK * 2);
    const size_t hstepA = (size_t)HALF * g.lda * 2, hstepB = (size_t)HALF * g.ldb * 2;
    const unsigned ldsw = (unsigned)wid * 1024u;
    const int aoff = lds_byte(wr * 64 + fr, fq * 8), boff = lds_byte(wc * 32 + fr, fq * 8);
#define PG8_SA(b, h) (((b) * 2 + (h)) * HTB)
#define PG8_SB(b, h) ((4 + (b) * 2 + (h)) * HTB)
#define PG8_STAGE(bufoff, gbase, voff) do { if constexpr (!(DBG & 1)) { _Pragma("unroll") for (int _i = 0; _i < 2; ++_i) { unsigned vo_ = (voff)[_i]; asm volatile("" : "+v"(vo_)); \
        __builtin_amdgcn_global_load_lds((const unsigned*)((const char*)(gbase) + vo_), (PG8_LAS unsigned*)(lds + (bufoff) + ldsw + _i * 8192), 16, 0, 0); } } } while (0)
#define PG8_LDA(dst, b, h) do { if constexpr (!(DBG & 2)) { _Pragma("unroll") for (int m = 0; m < 4; ++m) { dst[m].lo = *(const PG8_LAS bf16x8*)(lds + PG8_SA(b, h) + aoff + m * 2048); dst[m].hi = *(const PG8_LAS bf16x8*)(lds + PG8_SA(b, h) + aoff + m * 2048 + 1024); if constexpr ((DBG & 4) != 0) asm volatile("" :: "v"(dst[m])); } } } while (0)
#define PG8_LDB(dst, b, h) do { if constexpr (!(DBG & 2)) { _Pragma("unroll") for (int n = 0; n < 2; ++n) { dst[n].lo = *(const PG8_LAS bf16x8*)(lds + PG8_SB(b, h) + boff + n * 2048); dst[n].hi = *(const PG8_LAS bf16x8*)(lds + PG8_SB(b, h) + boff + n * 2048 + 1024); if constexpr ((DBG & 4) != 0) asm volatile("" :: "v"(dst[n])); } } } while (0)
#define PG8_MMA(ai, bj, At, Bt) do { if constexpr (!(DBG & 4)) { __builtin_amdgcn_s_setprio(1); _Pragma("unroll") for (int m = 0; m < 4; ++m) _Pragma("unroll") for (int n = 0; n < 2; ++n) { \
        if constexpr (KIND == 0) { acc[ai][bj][m][n] = __builtin_amdgcn_mfma_f32_16x16x32_bf16(Bt[n].lo, At[m].lo, acc[ai][bj][m][n], 0, 0, 0); acc[ai][bj][m][n] = __builtin_amdgcn_mfma_f32_16x16x32_bf16(Bt[n].hi, At[m].hi, acc[ai][bj][m][n], 0, 0, 0); } \
        else acc[ai][bj][m][n] = __builtin_amdgcn_mfma_scale_f32_16x16x128_f8f6f4(__builtin_bit_cast(v8i_t, Bt[n]), __builtin_bit_cast(v8i_t, At[m]), acc[ai][bj][m][n], 0, 0, 0, 0, 0, 0); }   \
        __builtin_amdgcn_s_setprio(0); } } while (0)
#define PG8_WAIT_V(n) asm volatile("s_waitcnt vmcnt(" #n ")" ::: "memory")
#define PG8_WAIT_L(n) asm volatile("s_waitcnt lgkmcnt(" #n ")" ::: "memory")
#define PG8_BAR do { if constexpr (!(DBG & 8)) __builtin_amdgcn_s_barrier(); } while (0)
#define PG8_SCHED __builtin_amdgcn_sched_barrier(0)
    Unit cur, nxt; int ui = 0;
    if (!S.next(0, cur)) return;
    f32x4 acc[2][2][4][2];
#pragma unroll
    for (int a = 0; a < 2; ++a)
#pragma unroll
        for (int b = 0; b < 2; ++b)
#pragma unroll
            for (int m = 0; m < 4; ++m)
#pragma unroll
                for (int n = 0; n < 2; ++n) acc[a][b][m][n] = (f32x4){0.f, 0.f, 0.f, 0.f};
    bf16x16 At[4], B0[2], B1[2];
    const char* cA = (const char*)g.A + cur.aoff; const char* cB = (const char*)g.Bt + cur.boff;
    S.a_ready(cur);
#define PG8_STAT_FETCH(un, par) do { if constexpr (Epi::NSTAT > 0) { if (wid < 2 * Epi::NSTAT) { const char* sp_ = (const char*)E.tab_src(wid >> 1, un); const int nb_ = E.tab_bytes(wid >> 1) - (wid & 1) * 1024; \
        int l3_; asm volatile("v_mbcnt_lo_u32_b32 %0, -1, 0\n\tv_mbcnt_hi_u32_b32 %0, -1, %0" : "=v"(l3_));   \
        if (sp_ && l3_ * 16 < nb_) __builtin_amdgcn_global_load_lds((const unsigned*)(sp_ + (wid & 1) * 1024 + l3_ * 16), (PG8_LAS unsigned*)(lds + STAT_TAB + ((par) * Epi::NSTAT + (wid >> 1)) * 2048 + (wid & 1) * 1024), 16, 0, 0); } } } while (0)
    PG8_STAT_FETCH(cur, 0);
    if constexpr (SP2) {
        PG8_STAGE(PG8_SB(0, 0), cB, voffB); PG8_STAGE(PG8_SB(0, 1), cB + hstepB, voffB); PG8_STAGE(PG8_SA(0, 0), cA, voffA); PG8_STAGE(PG8_SA(0, 1), cA + hstepA, voffA);
        if (wr == 1) PG8_BAR;
        PG8_WAIT_V(2); PG8_BAR;
        PG8_STAGE(PG8_SB(1, 0), cB + kstep, voffB); PG8_STAGE(PG8_SA(1, 0), cA + kstep, voffA); PG8_STAGE(PG8_SB(1, 1), cB + hstepB + kstep, voffB);
        PG8_WAIT_V(6); PG8_BAR;
    } else {
        PG8_STAGE(PG8_SB(0, 0), cB, voffB); PG8_STAGE(PG8_SA(0, 0), cA, voffA); PG8_STAGE(PG8_SB(0, 1), cB + hstepB, voffB); PG8_STAGE(PG8_SA(0, 1), cA + hstepA, voffA);
        if (wr == 1) PG8_BAR;
        PG8_WAIT_V(4); PG8_BAR;
        PG8_STAGE(PG8_SB(1, 0), cB + kstep, voffB); PG8_STAGE(PG8_SA(1, 0), cA + kstep, voffA); PG8_STAGE(PG8_SB(1, 1), cB + hstepB + kstep, voffB);
        PG8_WAIT_V(6); PG8_BAR;
    }
    if constexpr ((DBG & 2) != 0) {
#pragma unroll
        for (int m = 0; m < 4; ++m) { At[m].lo = *(const PG8_LAS bf16x8*)(lds + aoff + m * 2048); At[m].hi = *(const PG8_LAS bf16x8*)(lds + aoff + m * 2048 + 1024); }
#pragma unroll
        for (int n = 0; n < 2; ++n) { B0[n].lo = *(const PG8_LAS bf16x8*)(lds + 4 * HTB + boff + n * 2048); B0[n].hi = *(const PG8_LAS bf16x8*)(lds + 4 * HTB + boff + n * 2048 + 1024); B1[n] = B0[n]; }
    }
    for (;;) {
        const bool has_next = S.next(ui + 1, nxt);
        const char* nA = has_next ? (const char*)g.A + nxt.aoff : cA; const char* nB = has_next ? (const char*)g.Bt + nxt.boff : cB;
        for (int t = 0; t < nt; t += 2) {
            const bool last = (t == nt - 2);
            const char* a1 = cA + (size_t)(t + 1) * kstep;
            const char* a2 = last ? nA : cA + (size_t)(t + 2) * kstep; const char* b2 = last ? nB : cB + (size_t)(t + 2) * kstep;
            const char* a3 = a2 + kstep; const char* b3 = b2 + kstep;
            if (last && has_next) { S.a_ready(nxt); PG8_STAT_FETCH(nxt, (ui + 1) & 1); }
            if constexpr (SP2) {
            PG8_LDB(B0, 0, 0); PG8_LDB(B1, 0, 1); PG8_SCHED; PG8_LDA(At, 0, 0); PG8_STAGE(PG8_SA(1, 1), a1 + hstepA, voffA);
            PG8_WAIT_V(8); PG8_WAIT_L(0); PG8_BAR; PG8_MMA(0, 0, At, B0); PG8_MMA(0, 1, At, B1); PG8_BAR; PG8_SCHED;
            PG8_LDA(At, 0, 1); PG8_STAGE(PG8_SB(0, 0), b2, voffB); PG8_STAGE(PG8_SB(0, 1), b2 + hstepB, voffB); PG8_STAGE(PG8_SA(0, 0), a2, voffA);
            PG8_WAIT_V(8); PG8_WAIT_L(0); PG8_BAR; PG8_MMA(1, 0, At, B0); PG8_MMA(1, 1, At, B1); PG8_BAR; PG8_SCHED;
            PG8_LDB(B0, 1, 0); PG8_LDB(B1, 1, 1); PG8_SCHED; PG8_LDA(At, 1, 0); PG8_STAGE(PG8_SA(0, 1), a2 + hstepA, voffA);
            PG8_WAIT_V(8); PG8_WAIT_L(0); PG8_BAR; PG8_MMA(0, 0, At, B0); PG8_MMA(0, 1, At, B1); PG8_BAR; PG8_SCHED;
            PG8_LDA(At, 1, 1); PG8_STAGE(PG8_SB(1, 0), b3, voffB); PG8_STAGE(PG8_SB(1, 1), b3 + hstepB, voffB); PG8_STAGE(PG8_SA(1, 0), a3, voffA);
            PG8_WAIT_V(8); PG8_WAIT_L(0); PG8_BAR; PG8_MMA(1, 0, At, B0); PG8_MMA(1, 1, At, B1); PG8_BAR; PG8_SCHED;
            } else {
            PG8_LDB(B0, 0, 0); PG8_SCHED; PG8_LDA(At, 0, 0); PG8_STAGE(PG8_SA(1, 1), a1 + hstepA, voffA);
            PG8_WAIT_L(8); PG8_BAR; PG8_WAIT_L(0); PG8_MMA(0, 0, At, B0); PG8_BAR; PG8_SCHED;
            PG8_LDB(B1, 0, 1); PG8_STAGE(PG8_SB(0, 0), b2, voffB);
            PG8_BAR; PG8_WAIT_L(0); PG8_MMA(0, 1, At, B1); PG8_BAR;
            PG8_LDA(At, 0, 1); PG8_STAGE(PG8_SA(0, 0), a2, voffA);
            PG8_BAR; PG8_WAIT_L(0); PG8_MMA(1, 0, At, B0); PG8_BAR; PG8_SCHED;
            PG8_STAGE(PG8_SB(0, 1), b2 + hstepB, voffB);
            PG8_WAIT_V(6); PG8_BAR; PG8_MMA(1, 1, At, B1); PG8_BAR;
            PG8_LDB(B0, 1, 0); PG8_SCHED; PG8_LDA(At, 1, 0); PG8_STAGE(PG8_SA(0, 1), a2 + hstepA, voffA);
            PG8_WAIT_L(8); PG8_BAR; PG8_WAIT_L(0); PG8_MMA(0, 0, At, B0); PG8_BAR; PG8_SCHED;
            PG8_LDB(B1, 1, 1); PG8_STAGE(PG8_SB(1, 0), b3, voffB);
            PG8_BAR; PG8_WAIT_L(0); PG8_MMA(0, 1, At, B1); PG8_BAR;
            PG8_LDA(At, 1, 1); PG8_STAGE(PG8_SA(1, 0), a3, voffA);
            PG8_BAR; PG8_WAIT_L(0); PG8_MMA(1, 0, At, B0); PG8_BAR; PG8_SCHED;
            PG8_STAGE(PG8_SB(1, 1), b3 + hstepB, voffB);
            PG8_WAIT_V(6); PG8_BAR; PG8_MMA(1, 1, At, B1); PG8_BAR;
            }
        }
        if constexpr (ALIGN_EPI) { if (wr == 0) PG8_BAR; }
        if constexpr (!Epi::AFTER_DRAIN) { int l2_; asm volatile("v_mbcnt_lo_u32_b32 %0, -1, 0\n\tv_mbcnt_hi_u32_b32 %0, -1, %0" : "=v"(l2_)); if constexpr (Epi::NSTAT > 0) E(acc, cur, wr, wc, l2_ & 15, l2_ >> 4, lds + STAT_TAB + (ui & 1) * Epi::NSTAT * 2048); else E(acc, cur, wr, wc, l2_ & 15, l2_ >> 4); S.done(cur); }
        if (!has_next) break;
#pragma unroll
        for (int a = 0; a < 2; ++a)
#pragma unroll
            for (int b = 0; b < 2; ++b)
#pragma unroll
                for (int m = 0; m < 4; ++m)
#pragma unroll
                    for (int n = 0; n < 2; ++n) acc[a][b][m][n] = (f32x4){0.f, 0.f, 0.f, 0.f};
        cur = nxt; cA = nA; cB = nB; ++ui;
        if constexpr (ALIGN_EPI) { if (wr == 1) PG8_BAR; }
    }
    PG8_WAIT_V(0);
    if constexpr (!ALIGN_EPI) { if (wr == 0) PG8_BAR; }
    PG8_BAR;
    if constexpr (Epi::AFTER_DRAIN) { E.fused(acc, cur, wr, wc, fr, fq, lds, wid, lane); S.done(cur); }
#undef PG8_STAT_FETCH
#undef PG8_SA
#undef PG8_SB
#undef PG8_STAGE
#undef PG8_LDA
#undef PG8_LDB
#undef PG8_MMA
#undef PG8_WAIT_V
#undef PG8_WAIT_L
#undef PG8_BAR
#undef PG8_SCHED
}
}
#define XB_LAS LAS
#define XB_TMO      128
#define XB_XCNT(j)  (256  + 64 * (j))
#define XB_XSUB(j)  (1280 + 64 * (j))
#define XB_XGEN(j)  (2304 + 64 * (j))
#define XB_TOP      3328
#define XB_TOPGEN   3392
#define XCD_BAR_WORDS 3456
#define XB_SPIN_CAP (1u << 18)

__device__ __forceinline__ unsigned xb_ld(unsigned* p)              { return __hip_atomic_load(p, __ATOMIC_RELAXED, __HIP_MEMORY_SCOPE_AGENT); }
__device__ __forceinline__ unsigned xb_add(unsigned* p, unsigned v) { return __hip_atomic_fetch_add(p, v, __ATOMIC_RELAXED, __HIP_MEMORY_SCOPE_AGENT); }
__device__ __forceinline__ unsigned xb_xcc_id() { return (unsigned)__builtin_amdgcn_s_getreg((3 << 11) | 20) & 0xFu; }
#define XB_SPIN(cond, bar) do { unsigned _sp = 0; while (cond) { __builtin_amdgcn_s_sleep(1); \
    if ((++_sp & 255u) == 0u) { if (xb_ld(&(bar)[XB_TMO])) break; if (_sp > XB_SPIN_CAP) { atomicAdd(&(bar)[XB_TMO], 1u); break; } } } } while (0)

struct XcdBarrier {
    unsigned* bar; unsigned x;
    volatile LAS unsigned* st;
};

__device__ __forceinline__ XcdBarrier xcd_barrier_post(unsigned* bar, volatile LAS unsigned* st, const bool t0  ) {
    XcdBarrier b; b.bar = bar; b.x = xb_xcc_id(); b.st = st;
    if (t0) (void)xb_add(&bar[XB_XCNT(b.x)], 1u);
    return b;
}
__device__ __forceinline__ void xcd_barrier_complete(unsigned* bar, unsigned x, unsigned& nloc, unsigned& nx) {
    const unsigned G = gridDim.x * gridDim.y * gridDim.z;
    unsigned sum, cnt, mine, sp = 0u;
    for (;;) {
        sum = 0u; cnt = 0u; mine = 0u;
#pragma unroll
        for (unsigned j = 0; j < 16; ++j) { const unsigned c = xb_ld(&bar[XB_XCNT(j)]); sum += c; cnt += (c > 0u) ? 1u : 0u; mine = (j == x) ? c : mine; }
        if (sum == G) break;
        __builtin_amdgcn_s_sleep(1);
        if ((++sp & 255u) == 0u) { if (xb_ld(&bar[XB_TMO])) break; if (sp > XB_SPIN_CAP) { atomicAdd(&bar[XB_TMO], 1u); break; } }
    }
    nloc = mine > 0u ? mine : 1u; nx = cnt > 0u ? cnt : 1u;
}

__device__ __forceinline__ void xcd_barrier(const XcdBarrier& b, const bool t0  ) {
    asm volatile("s_waitcnt vmcnt(0)" ::: "memory");
    __syncthreads();
    if (t0) {
        unsigned* bar = b.bar;
        __builtin_amdgcn_s_waitcnt(0);
        unsigned nloc = b.st[0], nx = b.st[1];
        if (nloc == 0u) { xcd_barrier_complete(bar, b.x, nloc, nx); b.st[0] = nloc; b.st[1] = nx; }
        const unsigned old = xb_add(&bar[XB_XSUB(b.x)], 1u);
        const unsigned gen = old / nloc;
        if (old + 1u == (gen + 1u) * nloc) {
            __builtin_amdgcn_fence(__ATOMIC_RELEASE, "agent");
            asm volatile("s_waitcnt vmcnt(0)" ::: "memory");
            const unsigned og = xb_add(&bar[XB_TOP], 1u);
            const unsigned tg = og / nx;
            if (og + 1u == (tg + 1u) * nx) xb_add(&bar[XB_TOPGEN], 1u);
            else XB_SPIN(xb_ld(&bar[XB_TOPGEN]) == tg, bar);
            __builtin_amdgcn_fence(__ATOMIC_ACQUIRE, "agent");
            xb_add(&bar[XB_XGEN(b.x)], 1u);
            asm volatile("s_waitcnt vmcnt(0)" ::: "memory");
        } else {
            XB_SPIN(xb_ld(&bar[XB_XGEN(b.x)]) == gen, bar);
            __builtin_amdgcn_fence(__ATOMIC_ACQUIRE, "agent");
            asm volatile("s_waitcnt vmcnt(0)" ::: "memory");
        }
    }
    __syncthreads();
}

struct Frame {
    LAS unsigned char* lds;
    volatile LAS unsigned* MISC;
    gu32* ctl;
    int tid, lane, wave, vcu, G;
    const float* const* in;
    float* X;
    unsigned char* ws;
};
#define FIN(k) (F.in[k])
__device__ __forceinline__ fx64* ssq_arr(const Frame& F, int inst) { return (fx64*)(F.ws + WS_CTL + (size_t)CW_SSQ * 4) + (size_t)inst * TT; }
__device__ __forceinline__ bf16* wt(const Frame& F, int lp, size_t off) { return (bf16*)(F.ws + WS_WT + (size_t)lp * WT_PAIR + off); }
__device__ __forceinline__ unsigned char* fact(const Frame& F, size_t off) { return F.ws + WS_FACT + off; }

struct CvtJob { const float* W0; long w1off; const float* g; bf16* dst; int K, Nd, ldw, mode, nvalid, ldd; float f8scale; };
__device__ __forceinline__ const float* cvt_src(const CvtJob& j, int n) {
    if (j.mode == 0) return n < j.nvalid ? j.W0 + n : nullptr;
    if (j.mode == 1) { const int tile = n >> 8, w = n & 255; return j.W0 + (w < 128 ? 0L : j.w1off) + tile * 128 + (w & 127); }
    if (j.mode == 3) return j.W0 + (n < 128 ? (long)n : j.w1off + (n - 128));
    if (n < 640) return j.W0 + n;
    if (n < 704) { const int r = n - 640, w = r >> 5, q = (r >> 3) & 3, nn = (r >> 2) & 1, jj = r & 3; return j.W0 + 640 + nn * 32 + 16 * w + 4 * q + jj; }
    return nullptr;
}
struct CvtRegs { f32x4 v[8]; float g[8]; };
__device__ __forceinline__ void cvt_load(const CvtJob& j, int item, int lane, CvtRegs& R) { f32x4 (&v)[8] = R.v;
    const int nblk = j.Nd / 32, kb = item / nblk, nb = item % nblk, k0 = 64 * kb, n0 = 32 * nb;
    const float* src = cvt_src(j, n0 + 4 * (lane & 7));
#pragma unroll
    for (int i = 0; i < 8; ++i) { const int kk = 8 * i + (lane >> 3); v[i] = src ? __builtin_nontemporal_load((const GAS f32x4*)(src + (size_t)(k0 + kk) * j.ldw)) : (f32x4){0.f, 0.f, 0.f, 0.f}; }
    if (j.g) {
#pragma unroll
        for (int i = 0; i < 8; ++i) R.g[i] = j.g[k0 + 8 * i + (lane >> 3)]; }
}
__device__ __forceinline__ void cvt_store(const CvtJob& j, LAS float* scr, int item, int lane, CvtRegs& R) { f32x4 (&v)[8] = R.v;
    const int nblk = j.Nd / 32, kb = item / nblk, nb = item % nblk, k0 = 64 * kb, n0 = 32 * nb;
    if (j.g) {
#pragma unroll
        for (int i = 0; i < 8; ++i) v[i] = v[i] * R.g[i]; }
#pragma unroll
    for (int i = 0; i < 8; ++i) *(LAS f32x4*)(scr + (8 * i + (lane >> 3)) * 36 + 4 * ((lane & 7) ^ i)) = v[i];
    LDS_WAIT(); asm volatile("" ::: "memory");
#pragma unroll
    for (int jj = 0; jj < 4; ++jj) { const int p = lane + 64 * jj, n = p >> 3, c = p & 7; const LAS float* s = scr + (8 * c) * 36 + 4 * ((n >> 2) ^ c) + (n & 3);
        if (j.f8scale != 0.f) { const float sc = j.f8scale; int lo = 0, hi = 0;
            lo = __builtin_amdgcn_cvt_pk_fp8_f32(s[0 * 36] * sc, s[1 * 36] * sc, lo, false); lo = __builtin_amdgcn_cvt_pk_fp8_f32(s[2 * 36] * sc, s[3 * 36] * sc, lo, true);
            hi = __builtin_amdgcn_cvt_pk_fp8_f32(s[4 * 36] * sc, s[5 * 36] * sc, hi, false); hi = __builtin_amdgcn_cvt_pk_fp8_f32(s[6 * 36] * sc, s[7 * 36] * sc, hi, true);
            *(GAS v2u*)((unsigned char*)j.dst + (size_t)(n0 + n) * j.ldd + k0 + 8 * c) = (v2u){(unsigned)lo, (unsigned)hi}; }
        else {
        v4u o; o.x = pk2(s[0 * 36], s[1 * 36]); o.y = pk2(s[2 * 36], s[3 * 36]); o.z = pk2(s[4 * 36], s[5 * 36]); o.w = pk2(s[6 * 36], s[7 * 36]);
        *(GAS v4u*)(j.dst + (size_t)(n0 + n) * j.ldd + k0 + 8 * c) = o; } }
    LDS_WAIT(); asm volatile("" ::: "memory");
}
constexpr int JOBS_PER_PAIR = 32;
__device__ __forceinline__ CvtJob make_job(const Frame& F, int idx) {
    const int lp = idx / JOBS_PER_PAIR, k = idx % JOBS_PER_PAIR; CvtJob j; j.w1off = 0; j.g = nullptr; j.mode = 0; j.f8scale = 0.f; j.ldd = 0;
    if (k == 0) { j.W0 = FIN(4) + (size_t)lp * 1024 * 704; j.g = FIN(2) + (2 * lp) * 1024; j.dst = wt(F, lp, WO_WINA); j.K = 1024; j.Nd = 768; j.ldw = 704; j.mode = 2; j.nvalid = 704; }
    else if (k == 1) { j.W0 = FIN(6) + (size_t)lp * 384 * 1536; j.g = FIN(5) + lp * 384; j.dst = wt(F, lp, WO_WQB); j.K = 384; j.Nd = 1536; j.ldw = 1536; j.nvalid = 1536; j.ldd = CQ_LD; }
    else if (k == 2) { j.W0 = FIN(8) + (size_t)lp * 256 * 2048; j.g = FIN(7) + lp * 256; j.dst = wt(F, lp, WO_WKVB); j.K = 256; j.Nd = 2048; j.ldw = 2048; j.nvalid = 2048; j.ldd = CKV_LD; }
    else if (k == 3) { j.W0 = FIN(11) + (size_t)lp * 1024 * 1024; j.dst = wt(F, lp, WO_WO); j.K = 1024; j.Nd = 1024; j.ldw = 1024; j.nvalid = 1024; }
    else if (k == 4) { j.W0 = FIN(23) + (size_t)lp * 1024 * 2816; j.w1off = (FIN(24) + (size_t)lp * 1024 * 2816) - j.W0; j.g = FIN(3) + (2 * lp) * 1024; j.dst = wt(F, lp, WO_W13); j.K = 1024; j.Nd = 5632; j.ldw = 2816; j.mode = 1; j.nvalid = 5632; if (ffn_fu8(lp)) j.f8scale = 64.f; }
    else if (k == 5) { j.W0 = FIN(25) + (size_t)lp * 2816 * 1024; j.dst = wt(F, lp, WO_W2); j.K = 2816; j.Nd = 1024; j.ldw = 1024; j.nvalid = 1024; if (ffn_fd8(lp)) j.f8scale = 64.f; }
    else if (k == 6) { j.W0 = FIN(12) + (size_t)lp * 1024 * 2048; j.g = FIN(2) + (2 * lp + 1) * 1024; j.dst = wt(F, lp, WO_LIN); j.K = 1024; j.Nd = 2048; j.ldw = 2048; j.nvalid = 2048; if (lru_in8(lp)) j.f8scale = 64.f; }
    else if (k < 15) { const int h = k - 7; j.W0 = FIN(16) + ((size_t)lp * 8 + h) * 128 * 128; j.w1off = (FIN(18) + ((size_t)lp * 8 + h) * 128 * 128) - j.W0; j.dst = wt(F, lp, WO_WG) + (size_t)h * 256 * WG_LD; j.K = 128; j.Nd = 256; j.ldw = 128; j.mode = 3; j.nvalid = 256; j.ldd = WG_LD; }
    else if (k == 15) { j.W0 = FIN(21) + (size_t)lp * 1024 * 1024; j.dst = wt(F, lp, WO_WOUT); j.K = 1024; j.Nd = 1024; j.ldw = 1024; j.nvalid = 1024; if (lru_out8(lp)) j.f8scale = 64.f; }
    else if (k < 24) { const int e = k - 16; j.W0 = FIN(28) + ((size_t)lp * 8 + e) * 1024 * 3584; j.w1off = (FIN(29) + ((size_t)lp * 8 + e) * 1024 * 3584) - j.W0; j.g = FIN(3) + (2 * lp + 1) * 1024; j.dst = wt(F, lp, WO_M13) + (size_t)e * 7168 * 1024; j.K = 1024; j.Nd = 7168; j.ldw = 3584; j.mode = 1; j.nvalid = 7168;
        if (moe_f8(lp)) { j.f8scale = 64.f; j.dst = (bf16*)((unsigned char*)wt(F, lp, WO_M13) + (size_t)e * 7168 * MOE8_PITCH); j.ldd = MOE8_PITCH; } }
    else { const int e = k - 24; j.W0 = FIN(30) + ((size_t)lp * 8 + e) * 3584 * 1024; j.dst = wt(F, lp, WO_M2) + (size_t)e * 1024 * 3584; j.K = 3584; j.Nd = 1024; j.ldw = 1024; j.nvalid = 1024;
        if (moe_f8(lp)) { j.f8scale = 128.f; j.dst = (bf16*)((unsigned char*)wt(F, lp, WO_M2) + (size_t)e * 1024 * 3584); } }
    if (j.ldd == 0) j.ldd = j.K;
    return j;
}
__device__ __forceinline__ void prep_rows(const Frame& F, const float* src, float* dstX, fx64* ssq) {
    const int gw = F.vcu * NWAVES + F.wave, NGW = F.G * NWAVES; bf16* XB = (bf16*)fact(F, FA_XB);
    for (int m0 = gw; m0 < TT; m0 += 4 * NGW) {
        f32x4 v[4][4];
#pragma unroll
        for (int r = 0; r < 4; ++r) { const int m = m0 + r * NGW; if (m < TT) { const GAS f32x4* xr = (const GAS f32x4*)(src + (size_t)m * DM) + F.lane;
#pragma unroll
            for (int j = 0; j < 4; ++j) v[r][j] = xr[64 * j]; } }
#pragma unroll
        for (int r = 0; r < 4; ++r) { const int m = m0 + r * NGW; if (m < TT) { float s = 0.f;
#pragma unroll
            for (int j = 0; j < 4; ++j) s += (v[r][j].x * v[r][j].x + v[r][j].y * v[r][j].y) + (v[r][j].z * v[r][j].z + v[r][j].w * v[r][j].w);
            s = wave_sum(s, F.lane); if (F.lane == 0) ssq[m] = fx_of(s);
            if (dstX) { GAS f32x4* xo = (GAS f32x4*)(dstX + (size_t)m * DM) + F.lane;
#pragma unroll
                for (int j = 0; j < 4; ++j) xo[64 * j] = v[r][j]; }
            GAS v2u* o8 = (GAS v2u*)(XB + (size_t)m * DM) + F.lane;
#pragma unroll
            for (int j = 0; j < 4; ++j) { v2u w; w.x = pk2(v[r][j].x, v[r][j].y); w.y = pk2(v[r][j].z, v[r][j].w); o8[64 * j] = w; } } }
    }
}
__device__ __forceinline__ void cvt_jobs(const Frame& F, int job_lo, int job_hi, const int gw, const int NGW) {
    LAS float* scr = (LAS float*)(F.lds + RING_OFF + F.wave * 16384);
    if (gw < 0) return;
    long base = 0;
    for (int ji = job_lo; ji < job_hi; ++ji) {
        const CvtJob j = make_job(F, ji); const int nitems = (j.K / 64) * (j.Nd / 32);
        int it0 = (int)((gw - base) % NGW); if (it0 < 0) it0 += NGW;
        if (it0 < nitems) { CvtRegs va, vb; cvt_load(j, it0, F.lane, va);
            for (int it = it0; it < nitems; it += 2 * NGW) {
                const bool hb = it + NGW < nitems, ha = it + 2 * NGW < nitems;
                if (hb) cvt_load(j, it + NGW, F.lane, vb);
                cvt_store(j, scr, it, F.lane, va);
                if (ha) cvt_load(j, it + 2 * NGW, F.lane, va);
                if (hb) cvt_store(j, scr, it + NGW, F.lane, vb);
            } }
        base += nitems;
    }
}
#ifndef TAIL_SLOTS
#define TAIL_SLOTS 1
#endif
#ifndef LATE_SLOTS
#define LATE_SLOTS 1
#endif
__device__ __forceinline__ void tail_convert(const Frame& P, int job_lo, int job_hi, int first_idle) {
    const int c = (int)blockIdx.x; int l_; asm volatile("v_mbcnt_lo_u32_b32 %0, -1, 0\n\tv_mbcnt_hi_u32_b32 %0, -1, %0" : "=v"(l_));
    if (first_idle >= P.G) first_idle = 0;
    Frame Q_ = P; Q_.lane = l_; cvt_jobs(Q_, job_lo, job_hi, c >= first_idle ? (c - first_idle) * NWAVES + P.wave : -1, (P.G - first_idle) * NWAVES);
}
__device__ __forceinline__ void p0_prologue(const Frame& F, int job_lo, int job_hi, const bool rest = true) {
    LAS float* scr = (LAS float*)(F.lds + RING_OFF + F.wave * 16384);
    const int gw = F.vcu * NWAVES + F.wave, NGW = F.G * NWAVES;
    if (TAIL_SLOTS && job_lo == 0 && job_hi == 2 * JOBS_PER_PAIR) { if (LATE_SLOTS) { cvt_jobs(F, 0, 23, gw, NGW); cvt_jobs(F, 24, 31, gw, NGW); cvt_jobs(F, 32, 48, gw, NGW); job_lo = 61; job_hi = 62; }     else { cvt_jobs(F, 0, 48, gw, NGW); cvt_jobs(F, 55, 56, gw, NGW); job_lo = 59; job_hi = 64; } }
    long base = 0;
    for (int ji = job_lo; ji < job_hi; ++ji) {
        const CvtJob j = make_job(F, ji); const int nitems = (j.K / 64) * (j.Nd / 32);
        int it0 = (int)((gw - base) % NGW); if (it0 < 0) it0 += NGW;
        if (it0 < nitems) { CvtRegs va, vb; cvt_load(j, it0, F.lane, va);
            for (int it = it0; it < nitems; it += 2 * NGW) {
                const bool hb = it + NGW < nitems, ha = it + 2 * NGW < nitems;
                if (hb) cvt_load(j, it + NGW, F.lane, vb);
                cvt_store(j, scr, it, F.lane, va);
                if (ha) cvt_load(j, it + 2 * NGW, F.lane, va);
                if (hb) cvt_store(j, scr, it + NGW, F.lane, vb);
            } }
        base += nitems;
    }
    if (!rest) return;
    { float* cs = (float*)fact(F, FA_ROPE); const int* pos = (const int*)F.in[1];
      for (int i = (F.vcu * NWAVES + F.wave) * 64 + F.lane; i < TT * 32; i += NGW * 64) { const int t = i >> 5, fi = i & 31;
          const float inv = 1.0f / powf(10000.0f, (float)(2 * fi) / 64.0f); const float ang = (float)pos[t] * inv; cs[i] = cosf(ang); cs[TT * 32 + i] = sinf(ang); } }
    { float* coef = (float*)fact(F, FA_COEF); const float* lam = F.in[20];
      for (int i = (F.vcu * NWAVES + F.wave) * 64 + F.lane; i < 2048; i += NGW * 64) { const float L = lam[i]; const float ls = (L >= 0.f) ? -log1pf(expf(-L)) : (L - log1pf(expf(L))); coef[i] = 8.f * ls * 1.4426950408889634f; } }
    { unsigned char* rb = fact(F, FA_RB);
      for (int i = (F.vcu * NWAVES + F.wave) * 64 + F.lane; i < 2 * 32 * 64; i += NGW * 64) { const int l2 = i >> 11, r = i & 2047, ks = r >> 6, ln = r & 63, fq = ln >> 4, fr = ln & 15, e = fr & 7;
          const float* wr = F.in[26] + l2 * 8192; const float* g = F.in[3] + (2 * l2 + 1) * 1024; unsigned w[4];
#pragma unroll
          for (int p2 = 0; p2 < 4; ++p2) { unsigned h[2];
#pragma unroll
              for (int q = 0; q < 2; ++q) { const int k = 32 * ks + 8 * fq + 2 * p2 + q; const float wf = g[k] * wr[k * 8 + e]; const unsigned hi = f2bf(wf); h[q] = fr < 8 ? hi : f2bf(wf - __builtin_bit_cast(float, hi << 16)); }
              w[p2] = h[0] | (h[1] << 16); }
          *(v4u*)(rb + (size_t)i * 16) = (v4u){w[0], w[1], w[2], w[3]}; } }
    prep_rows(F, F.in[0], F.X, ssq_arr(F, 0));
}

namespace pg8 {
struct EpiSwiGLU {
    static constexpr bool PERM = true, AFTER_DRAIN = false; static constexpr int NSTAT = 1;
    bf16_t* H; int ldh; const fx64* ssq; int tpg; int f8out; float accscale;
    __device__ __forceinline__ const void* tab_src(int, const Unit& u) const { return ssq ? ssq + (size_t)u.pm * BM : nullptr; }
    __device__ __forceinline__ int tab_bytes(int) const { return 2048; }
    __device__ __forceinline__ void operator()(const f32x4 (&acc)[2][2][4][2], const Unit& u, int wr, int wc, int fr, int fq, const PG8_LAS unsigned char* tab) const {
        const int row0 = u.pm * BM + wr * 64 + fr, col0 = (u.pn % tpg) * 128 + wc * 32 + 8 * fq;
        float rsv[2][4];
#pragma unroll
        for (int ai = 0; ai < 2; ++ai)
#pragma unroll
            for (int m = 0; m < 4; ++m) rsv[ai][m] = ssq ? fx_to(*(const PG8_LAS unsigned long long*)(tab + (wr * 64 + fr + ai * HALF + m * 16) * 8)) : 0.f;
        const float ias2 = 1.f / (accscale * accscale);
#pragma unroll
        for (int ai = 0; ai < 2; ++ai)
#pragma unroll
            for (int m = 0; m < 4; ++m) { const int row = row0 + ai * HALF + m * 16;
                float c1, is2;
                if (ssq) { const float v = rsv[ai][m] * (1.f / 1024.f) + NEPS; c1 = __builtin_amdgcn_rsqf(v) * accscale * -1.4426950408889634f; is2 = v * ias2; }
                else { c1 = accscale * -1.4426950408889634f; is2 = ias2; }
                const float c0 = __builtin_amdgcn_logf(is2);
                float t[8], p[8], h[8];
#pragma unroll
                for (int n = 0; n < 2; ++n)
#pragma unroll
                    for (int j = 0; j < 4; ++j) { const float a = acc[ai][0][m][n][j]; t[4 * n + j] = __builtin_fmaf(a, c1, c0); p[4 * n + j] = a * acc[ai][1][m][n][j]; }
                __builtin_amdgcn_sched_barrier(0);
#pragma unroll
                for (int k = 0; k < 8; ++k) t[k] = __builtin_amdgcn_exp2f(t[k]);
                __builtin_amdgcn_sched_barrier(0);
#pragma unroll
                for (int k = 0; k < 8; ++k) t[k] = t[k] + is2;
                __builtin_amdgcn_sched_barrier(0);
#pragma unroll
                for (int k = 0; k < 8; ++k) t[k] = __builtin_amdgcn_rcpf(t[k]);
                __builtin_amdgcn_sched_barrier(0);
#pragma unroll
                for (int k = 0; k < 8; ++k) h[k] = p[k] * t[k];
                if (f8out) { int lo = 0, hi = 0; lo = __builtin_amdgcn_cvt_pk_fp8_f32(h[0], h[1], lo, false); lo = __builtin_amdgcn_cvt_pk_fp8_f32(h[2], h[3], lo, true);
                    hi = __builtin_amdgcn_cvt_pk_fp8_f32(h[4], h[5], hi, false); hi = __builtin_amdgcn_cvt_pk_fp8_f32(h[6], h[7], hi, true);
                    *(v2u*)((unsigned char*)H + (size_t)row * ldh + col0) = (v2u){(unsigned)lo, (unsigned)hi}; }
                else { u32x4 w; w.x = pk2(h[0], h[1]); w.y = pk2(h[2], h[3]); w.z = pk2(h[4], h[5]); w.w = pk2(h[6], h[7]);
                *(u32x4*)(H + (size_t)row * ldh + col0) = w; } }
    }
};
struct EpiResid {
    static constexpr bool PERM = true, AFTER_DRAIN = false; static constexpr int NSTAT = 0;
    float* X; bf16_t* XB; fx64* ssq_out; const float* bias;
#if FFN_F8
    unsigned char* XB8; float accscale;
#else
    static constexpr unsigned char* XB8 = nullptr; static constexpr float accscale = 1.f;
#endif
    __device__ __forceinline__ void operator()(const f32x4 (&acc)[2][2][4][2], const Unit& u, int wr, int wc, int fr, int fq) const {
        const int row0 = u.pm * BM + wr * 64 + fr, col0 = u.pn * BM + wc * 32 + 8 * fq;
        f32x4 bv[2][2];
#pragma unroll
        for (int bj = 0; bj < 2; ++bj)
#pragma unroll
            for (int n = 0; n < 2; ++n) bv[bj][n] = bias ? *(const f32x4*)(bias + col0 + bj * HALF + 4 * n) : (f32x4){0.f, 0.f, 0.f, 0.f};
        f32x4 xr[4][2][2];
#pragma unroll
        for (int m = 0; m < 4; ++m)
#pragma unroll
            for (int bj = 0; bj < 2; ++bj) { const float* xp = X + (size_t)(row0 + m * 16) * DM + col0 + bj * HALF; xr[m][bj][0] = *(const f32x4*)xp; xr[m][bj][1] = *(const f32x4*)(xp + 4); }
#pragma unroll
        for (int ai = 0; ai < 2; ++ai) {
#pragma unroll
            for (int m = 0; m < 4; ++m) { const int row = row0 + ai * HALF + m * 16; float s = 0.f; f32x4 v0[2], v1[2];
#pragma unroll
                for (int bj = 0; bj < 2; ++bj) { v0[bj] = xr[m][bj][0] + acc[ai][bj][m][0] * accscale + bv[bj][0]; v1[bj] = xr[m][bj][1] + acc[ai][bj][m][1] * accscale + bv[bj][1]; }
                if (ai == 0) {
#pragma unroll
                    for (int bj = 0; bj < 2; ++bj) { const float* xp = X + (size_t)(row0 + HALF + m * 16) * DM + col0 + bj * HALF; xr[m][bj][0] = *(const f32x4*)xp; xr[m][bj][1] = *(const f32x4*)(xp + 4); } }
#pragma unroll
                for (int bj = 0; bj < 2; ++bj) { float* xp = X + (size_t)row * DM + col0 + bj * HALF;
                    *(f32x4*)xp = v0[bj]; *(f32x4*)(xp + 4) = v1[bj];
                    s += (v0[bj][0] * v0[bj][0] + v0[bj][1] * v0[bj][1]) + (v0[bj][2] * v0[bj][2] + v0[bj][3] * v0[bj][3]) + (v1[bj][0] * v1[bj][0] + v1[bj][1] * v1[bj][1]) + (v1[bj][2] * v1[bj][2] + v1[bj][3] * v1[bj][3]);
                    u32x4 w; w.x = pk2(v0[bj][0], v0[bj][1]); w.y = pk2(v0[bj][2], v0[bj][3]); w.z = pk2(v1[bj][0], v1[bj][1]); w.w = pk2(v1[bj][2], v1[bj][3]);
                    if (XB) *(u32x4*)(XB + (size_t)row * DM + col0 + bj * HALF) = w;
                    if (XB8) { int lo = 0, hi = 0; lo = __builtin_amdgcn_cvt_pk_fp8_f32(v0[bj][0], v0[bj][1], lo, false); lo = __builtin_amdgcn_cvt_pk_fp8_f32(v0[bj][2], v0[bj][3], lo, true);
                        hi = __builtin_amdgcn_cvt_pk_fp8_f32(v1[bj][0], v1[bj][1], hi, false); hi = __builtin_amdgcn_cvt_pk_fp8_f32(v1[bj][2], v1[bj][3], hi, true);
                        *(v2u*)(XB8 + (size_t)row * DM + col0 + bj * HALF) = (v2u){(unsigned)lo, (unsigned)hi}; } }
                { const int ln_ = fq * 16 + fr; s += xshfl(s, 16, ln_); s += xshfl(s, 32, ln_); }
                if (ssq_out && fq == 0) fx_add(ssq_out + row, s); } }
    }
};
}
constexpr int MAXSLOT = 136 * 256;
constexpr size_t SL_TOKSLOT = 0, SL_GATE = 256 * 1024, SL_SSQ = 512 * 1024  , SL_RE = 1024 * 1024, SL_RW = 1280 * 1024, SL_RSSQ = 1536 * 1024;

__device__ __forceinline__ void r1_phase(const Frame& F, int lp) {
    const float* br = FIN(27) + lp * 8;
    int* r_e = (int*)fact(F, FA_SLOT + SL_RE); float* r_w = (float*)fact(F, FA_SLOT + SL_RW); float* r_ssq = (float*)fact(F, FA_SLOT + SL_RSSQ);
    LAS unsigned* cnt = (LAS unsigned*)(F.lds + XCH_OFF);
    LAS unsigned char* bimg = F.lds + RING_OFF; LAS float* xpart = (LAS float*)(F.lds + RING_OFF + 32768);
    if (F.tid < 8) cnt[F.tid] = 0u;
    { const unsigned char* rb = fact(F, FA_RB) + (size_t)lp * 32768;
#pragma unroll
      for (int j = 0; j < 4; ++j) __builtin_amdgcn_global_load_lds((const unsigned*)(rb + (F.wave * 4 + j) * 1024 + F.lane * 16), (LAS unsigned*)(bimg + (F.wave * 4 + j) * 1024), 16, 0, 0); }
    float bre[8];
#pragma unroll
    for (int e = 0; e < 8; ++e) bre[e] = br[e];
    const int gic = F.wave >> 1, kh = F.wave & 1, fr = F.lane & 15, fq = F.lane >> 4;
    for (int it = 0; it * F.G * 4 < TT / 16; ++it) {
        const int gi = (it * F.G + F.vcu) * 4 + gic; const bool valid = gi < TT / 16;
        f32x4 xa[16][2];
        if (valid) { const GAS f32x4* xp = (const GAS f32x4*)(F.X + (size_t)(gi * 16 + fr) * DM + kh * 512 + 8 * fq);
#pragma unroll
            for (int ks = 0; ks < 16; ++ks) { xa[ks][0] = xp[8 * ks]; xa[ks][1] = xp[8 * ks + 1]; } }
        VM_WAIT(); __syncthreads();
        f32x4 acc = {0.f, 0.f, 0.f, 0.f}; float s = 0.f;
        if (valid) {
#pragma unroll
            for (int ks = 0; ks < 16; ++ks) { const pg8::bf16x8 bfrag = *(const LAS pg8::bf16x8*)(bimg + (kh * 16 + ks) * 1024 + F.lane * 16);
                const f32x4 a = xa[ks][0], b = xa[ks][1];
                s += ((a.x * a.x + a.y * a.y) + (a.z * a.z + a.w * a.w)) + ((b.x * b.x + b.y * b.y) + (b.z * b.z + b.w * b.w));
                const v4u hi = {pk2c(a.x, a.y), pk2c(a.z, a.w), pk2c(b.x, b.y), pk2c(b.z, b.w)};
                const v4u lo = {pk2c(a.x - bflo(hi.x), a.y - bfhi(hi.x)), pk2c(a.z - bflo(hi.y), a.w - bfhi(hi.y)), pk2c(b.x - bflo(hi.z), b.y - bfhi(hi.z)), pk2c(b.z - bflo(hi.w), b.w - bfhi(hi.w))};
                acc = __builtin_amdgcn_mfma_f32_16x16x32_bf16(bfrag, __builtin_bit_cast(pg8::bf16x8, hi), acc, 0, 0, 0);
                acc = __builtin_amdgcn_mfma_f32_16x16x32_bf16(bfrag, __builtin_bit_cast(pg8::bf16x8, lo), acc, 0, 0, 0); }
            s += xshfl(s, 16, F.lane); s += xshfl(s, 32, F.lane);
            if (kh == 1) { LAS float* d = xpart + (gic * 64 + F.lane) * 5; d[0] = acc[0]; d[1] = acc[1]; d[2] = acc[2]; d[3] = acc[3]; d[4] = s; }
        }
        __syncthreads();
        if (valid && kh == 0) { const LAS float* d = xpart + (gic * 64 + F.lane) * 5; acc[0] += d[0]; acc[1] += d[1]; acc[2] += d[2]; acc[3] += d[3]; s += d[4];
            float lg[8];
#pragma unroll
            for (int r = 0; r < 4; ++r) lg[r] = acc[r] + xshfl(acc[r], 32, F.lane);
#pragma unroll
            for (int r = 0; r < 4; ++r) lg[4 + r] = xshfl(lg[r], 16, F.lane);
            if (fq == 0) { const float rs = 1.0f / sqrtf(s * (1.f / 1024.f) + NEPS);
#pragma unroll
                for (int e = 0; e < 8; ++e) lg[e] = lg[e] * rs + bre[e];
                int e1 = 0; float v1 = lg[0];
#pragma unroll
                for (int e = 1; e < 8; ++e) if (lg[e] > v1) { v1 = lg[e]; e1 = e; }
                int e2 = -1; float v2 = -3.0e38f;
#pragma unroll
                for (int e = 0; e < 8; ++e) if (e != e1 && lg[e] > v2) { v2 = lg[e]; e2 = e; }
                const int m = gi * 16 + fr; const float p2 = expf(v2 - v1), inv = 1.f / (1.f + p2); r_e[m] = e1 | (e2 << 8); r_w[2 * m] = inv; r_w[2 * m + 1] = p2 * inv; r_ssq[m] = s;
                __hip_atomic_fetch_add(cnt + e1, 1u, __ATOMIC_RELAXED, __HIP_MEMORY_SCOPE_WORKGROUP); __hip_atomic_fetch_add(cnt + e2, 1u, __ATOMIC_RELAXED, __HIP_MEMORY_SCOPE_WORKGROUP); } }
        __syncthreads();
    }
    if (F.tid < 8) __hip_atomic_fetch_add(F.ctl + CW_MOE + 64 * lp + F.tid, cnt[F.tid], RLX_AGENT);
}

struct MoeSeg { int np[8], ps[8], total; };
__device__ __forceinline__ MoeSeg moe_segments(const Frame& F, int lp) {
    MoeSeg s; int acc = 0;
    const unsigned cv = __hip_atomic_load(F.ctl + CW_MOE + 64 * lp + (F.lane & 7), RLX_AGENT);
#pragma unroll
    for (int e = 0; e < 8; ++e) { const int c = (int)__builtin_amdgcn_readlane((int)cv, e); s.np[e] = (c + 255) >> 8; s.ps[e] = acc; acc += s.np[e]; }
    s.total = acc; return s;
}

__device__ __forceinline__ void r2_phase(const Frame& F, int lp) {
    const MoeSeg sg = moe_segments(F, lp);
    const int* r_e = (const int*)fact(F, FA_SLOT + SL_RE); const float* r_w = (const float*)fact(F, FA_SLOT + SL_RW); const float* r_ssq = (const float*)fact(F, FA_SLOT + SL_RSSQ);
    int* tok_slot = (int*)fact(F, FA_SLOT + SL_TOKSLOT); float* slot_gate = (float*)fact(F, FA_SLOT + SL_GATE); fx64* slot_ssq = (fx64*)fact(F, FA_SLOT + SL_SSQ);
    const bf16* XB = (const bf16*)fact(F, FA_XB); bf16* AS = (bf16*)fact(F, FA_AS);
    LAS int* slots = (LAS int*)(F.lds + XCH_OFF + 64);
    for (int grp = blockIdx.x; grp < TT / 64; grp += F.G) {
        v4u ra[8], rb_[8]; float rq[8];
        if (moe_f8(lp)) {
#pragma unroll
            for (int i = 0; i < 8; ++i) { const int t = grp * 64 + 8 * F.wave + i; const GAS v4u* src = (const GAS v4u*)(XB + (size_t)t * DM) + 2 * F.lane; ra[i] = src[0]; rb_[i] = src[1]; rq[i] = r_ssq[t]; } }
        if (F.wave == 0) {
            const int t = grp * 64 + F.lane; const int re = r_e[t]; const int ek[2] = {re & 255, re >> 8};
            const f32x2 gw2 = *(const GAS f32x2*)(r_w + 2 * t); const float rs2 = r_ssq[t];
            unsigned long long mk[2][8]; int my_n = 0;
#pragma unroll
            for (int k = 0; k < 2; ++k)
#pragma unroll
                for (int e = 0; e < 8; ++e) { mk[k][e] = __ballot(ek[k] == e); if (F.lane == 8 * k + e) my_n = __popcll(mk[k][e]); }
            unsigned base = 0u;
            if (F.lane < 16 && my_n > 0) base = __hip_atomic_fetch_add(F.ctl + CW_MOE + 64 * lp + 16 + (F.lane & 7), (unsigned)my_n, RLX_AGENT);
#pragma unroll
            for (int k = 0; k < 2; ++k) { const int e = ek[k]; unsigned long long mm = mk[k][0]; int pse = sg.ps[0];
#pragma unroll
                for (int q = 1; q < 8; ++q) { if (e == q) { mm = mk[k][q]; pse = sg.ps[q]; } }
                const int slot = pse * 256 + ishfl((int)base, 8 * k + e) + __popcll(mm & ((1ull << F.lane) - 1ull));
                slots[k * 64 + F.lane] = slot; tok_slot[2 * t + k] = slot; slot_gate[slot] = k ? gw2.y : gw2.x; slot_ssq[slot] = fx_of(rs2); }
        }
        __syncthreads();
#pragma unroll
        for (int i = 0; i < 8; ++i) { const int tl = 8 * F.wave + i, t = grp * 64 + tl; const int s1 = slots[tl], s2 = slots[64 + tl];
            if (moe_f8(lp)) {
                const v4u a = ra[i], b = rb_[i]; int w0 = 0, w1 = 0, w2 = 0, w3 = 0; const float rn = rstd_of(rq[i], 1.f / 1024.f);
                w0 = __builtin_amdgcn_cvt_pk_fp8_f32(bflo(a.x) * rn, bfhi(a.x) * rn, w0, false); w0 = __builtin_amdgcn_cvt_pk_fp8_f32(bflo(a.y) * rn, bfhi(a.y) * rn, w0, true);
                w1 = __builtin_amdgcn_cvt_pk_fp8_f32(bflo(a.z) * rn, bfhi(a.z) * rn, w1, false); w1 = __builtin_amdgcn_cvt_pk_fp8_f32(bflo(a.w) * rn, bfhi(a.w) * rn, w1, true);
                w2 = __builtin_amdgcn_cvt_pk_fp8_f32(bflo(b.x) * rn, bfhi(b.x) * rn, w2, false); w2 = __builtin_amdgcn_cvt_pk_fp8_f32(bflo(b.y) * rn, bfhi(b.y) * rn, w2, true);
                w3 = __builtin_amdgcn_cvt_pk_fp8_f32(bflo(b.z) * rn, bfhi(b.z) * rn, w3, false); w3 = __builtin_amdgcn_cvt_pk_fp8_f32(bflo(b.w) * rn, bfhi(b.w) * rn, w3, true);
                const v4u o = {(unsigned)w0, (unsigned)w1, (unsigned)w2, (unsigned)w3};
                *((GAS v4u*)((unsigned char*)AS + (size_t)s1 * MOE8_PITCH) + F.lane) = o; *((GAS v4u*)((unsigned char*)AS + (size_t)s2 * MOE8_PITCH) + F.lane) = o;
            } else {
            const GAS v4u* src = (const GAS v4u*)(XB + (size_t)t * DM) + F.lane; const v4u a = src[0], b = src[64];
            GAS v4u* d1 = (GAS v4u*)(AS + (size_t)s1 * DM) + F.lane; GAS v4u* d2 = (GAS v4u*)(AS + (size_t)s2 * DM) + F.lane;
            d1[0] = a; d1[64] = b; d2[0] = a; d2[64] = b; } }
        __syncthreads();
    }
}

__device__ __forceinline__ void cb_sum_parts(const bf16* YP, int slot, int lane, v2u (&out)[4]) {
    const int pp = (slot >> 8) - 128, r = slot & 255; v2u part[KSPLIT_N][4];
#pragma unroll
    for (int k = 0; k < KSPLIT_N; ++k) { const GAS v2u* yp = (const GAS v2u*)(YP + ((size_t)(k * 8 + pp) * 256 + r) * DM) + lane;
#pragma unroll
        for (int j = 0; j < 4; ++j) part[k][j] = yp[64 * j]; }
#pragma unroll
    for (int j = 0; j < 4; ++j) { float a0 = 0.f, a1 = 0.f, a2 = 0.f, a3 = 0.f;
#pragma unroll
        for (int k = 0; k < KSPLIT_N; ++k) { a0 += bflo(part[k][j].x); a1 += bfhi(part[k][j].x); a2 += bflo(part[k][j].y); a3 += bfhi(part[k][j].y); }
        out[j].x = pk2(a0, a1); out[j].y = pk2(a2, a3); }
}
__device__ __forceinline__ void cb_phase(const Frame& F, int lp) {
    const int* tok_slot = (const int*)fact(F, FA_SLOT + SL_TOKSLOT); const bf16* Y = (const bf16*)fact(F, FA_Y); bf16* XB = (bf16*)fact(F, FA_XB); const float* r_w = (const float*)fact(F, FA_SLOT + SL_RW);
    fx64* ssq = ssq_arr(F, lp == 0 ? 4 : 7);
    const int gw = F.vcu * NWAVES + F.wave, NGW = F.G * NWAVES;
    const bool split = moe_ksplit(lp); const bf16* YP = (const bf16*)fact(F, FA_AS);
    for (int m0 = gw; m0 < TT; m0 += 8 * NGW) {
        v2u sl[8]; f32x2 gg[8];
#pragma unroll
        for (int i = 0; i < 8; ++i) { const int m = m0 + i * NGW; if (m < TT) { sl[i] = *(const GAS v2u*)(tok_slot + 2 * m); gg[i] = *(const GAS f32x2*)(r_w + 2 * m); } }
        f32x4 xv[2][4]; v2u ya[2][4], yb[2][4];
#define CB_LOAD(i_) do { const int m_ = m0 + (i_) * NGW; if (m_ < TT) { const GAS f32x4* xr_ = (const GAS f32x4*)(F.X + (size_t)m_ * DM) + F.lane; const GAS v2u* y1_ = (const GAS v2u*)(Y + (size_t)sl[i_].x * DM) + F.lane; const GAS v2u* y2_ = (const GAS v2u*)(Y + (size_t)sl[i_].y * DM) + F.lane; \
            _Pragma("unroll") for (int j = 0; j < 4; ++j) { xv[(i_) & 1][j] = xr_[64 * j]; ya[(i_) & 1][j] = y1_[64 * j]; yb[(i_) & 1][j] = y2_[64 * j]; } \
            if (split) { if ((int)(sl[i_].x >> 8) >= 128) cb_sum_parts(YP, (int)sl[i_].x, F.lane, ya[(i_) & 1]); if ((int)(sl[i_].y >> 8) >= 128) cb_sum_parts(YP, (int)sl[i_].y, F.lane, yb[(i_) & 1]); } } } while (0)
        CB_LOAD(0);
#pragma unroll
        for (int i = 0; i < 8; ++i) { const int m = m0 + i * NGW;
            if (i + 1 < 8) CB_LOAD(i + 1);
            if (m < TT) { const float g1 = gg[i].x, g2 = gg[i].y; GAS f32x4* xr = (GAS f32x4*)(F.X + (size_t)m * DM) + F.lane; GAS v2u* o8 = (GAS v2u*)(XB + (size_t)m * DM) + F.lane; float s = 0.f;
#pragma unroll
                for (int j = 0; j < 4; ++j) { f32x4 v = xv[i & 1][j]; const v2u a = ya[i & 1][j], b = yb[i & 1][j];
                    v.x += g1 * bflo(a.x) + g2 * bflo(b.x); v.y += g1 * bfhi(a.x) + g2 * bfhi(b.x); v.z += g1 * bflo(a.y) + g2 * bflo(b.y); v.w += g1 * bfhi(a.y) + g2 * bfhi(b.y);
                    xr[64 * j] = v; s += (v.x * v.x + v.y * v.y) + (v.z * v.z + v.w * v.w);
                    if (lp == 0) { v2u wv; wv.x = pk2(v.x, v.y); wv.y = pk2(v.z, v.w); o8[64 * j] = wv; } }
                if (lp == 0) { s = wave_sum(s, F.lane); if (F.lane == 0) ssq[m] = fx_of(s); } }
        }
#undef CB_LOAD
    }
}

namespace pg8 {
struct MoeOrder {
    int np[8], ps[8]; int ntile, U, G, c; long astep, bstep; int probe_same;
    __device__ __forceinline__ void init(const MoeSeg& s, int ntile_, int G_, int c_, int lda, int ldb) {
#pragma unroll
        for (int e = 0; e < 8; ++e) { np[e] = s.np[e]; ps[e] = s.ps[e]; }
        ntile = ntile_; U = s.total * ntile_; G = G_; c = c_; astep = (long)BM * lda * 2; bstep = (long)BM * ldb * 2; probe_same = 0; }
    __device__ __forceinline__ bool next(int i, Unit& u) const {
        const int L = i * G + c; if (L >= U) return false;
        int wgid = (int)L; { const int q = U / NXCD, r = U % NXCD, xcd = wgid % NXCD, off = wgid / NXCD; wgid = (xcd < r ? xcd * (q + 1) : r * (q + 1) + (xcd - r) * q) + off; }
        int e = 0, li = wgid, npe = np[0], pse = ps[0];
#pragma unroll
        for (int k = 1; k < 8; ++k) { const int ue = npe * ntile; const bool adv = (e == k - 1) && (li >= ue); li = adv ? li - ue : li; e = adv ? k : e; npe = adv ? np[k] : npe; pse = adv ? ps[k] : pse; }
        const int nig = WGM * ntile, gid = li / nig, fm = gid * WGM, gsz = (npe - fm) < WGM ? (npe - fm) : WGM, rem = li % nig;
        u.pm = __builtin_amdgcn_readfirstlane(pse + fm + rem % gsz); u.pn = __builtin_amdgcn_readfirstlane(e * ntile + rem / gsz); u.aoff = u.pm * astep; u.boff = u.pn * bstep;
#ifdef PROBE_EXTRA
        if (probe_same & 1) u.boff = 0; if (probe_same & 2) u.aoff = 0;
#endif
        return true;
    }
    __device__ __forceinline__ void a_ready(const Unit&) const {}
    __device__ __forceinline__ void done(const Unit&) const {}
};
constexpr int KSPLIT = 7, KSPLIT_BYTES = 4 * 128;
struct SplitOrder {
    int np[8], ps[8]; int V, G, c; long astep, bstep;
    __device__ __forceinline__ void init(const MoeSeg& s, int G_, int c_, int lda, int ldb) {
#pragma unroll
        for (int e = 0; e < 8; ++e) { np[e] = s.np[e]; ps[e] = s.ps[e]; }
        V = (s.total > 128 ? s.total - 128 : 0) * 4 * KSPLIT; G = G_; c = c_; astep = (long)BM * lda * 2; bstep = (long)BM * ldb * 2; }
    __device__ __forceinline__ bool next(int i, Unit& u) const {
        const int L = i * G + c; if (L >= V) return false;
        const int kpart = L % KSPLIT, t = L / KSPLIT, n = t & 3, pp = t >> 2, p = 128 + pp;
        int e = 0;
#pragma unroll
        for (int k = 1; k < 8; ++k) e = (p >= ps[k] && np[k] > 0) ? k : e;
        u.pm = __builtin_amdgcn_readfirstlane(kpart * 8 + pp); u.pn = __builtin_amdgcn_readfirstlane(e * 4 + n);
        u.aoff = (long)p * astep + kpart * KSPLIT_BYTES; u.boff = (long)(e * 4 + n) * bstep + kpart * KSPLIT_BYTES; return true;
    }
    __device__ __forceinline__ void a_ready(const Unit&) const {}
    __device__ __forceinline__ void done(const Unit&) const {}
};
struct EpiScaleBf16 {
    static constexpr bool PERM = true, AFTER_DRAIN = false; static constexpr int NSTAT = 0;
    bf16_t* Y; int ldy; const float* rowscale; int tpg; float accscale;
    __device__ __forceinline__ void operator()(const f32x4 (&acc)[2][2][4][2], const Unit& u, int wr, int wc, int fr, int fq) const {
        const int row0 = u.pm * BM + wr * 64 + fr, col0 = (u.pn % tpg) * BM + wc * 32 + 8 * fq;
        float sc[2][4];
#pragma unroll
        for (int ai = 0; ai < 2; ++ai)
#pragma unroll
            for (int m = 0; m < 4; ++m) sc[ai][m] = rowscale ? rowscale[row0 + ai * HALF + m * 16] * accscale : accscale;
#pragma unroll
        for (int ai = 0; ai < 2; ++ai)
#pragma unroll
            for (int m = 0; m < 4; ++m) { const int row = row0 + ai * HALF + m * 16; const float s = sc[ai][m];
#pragma unroll
                for (int bj = 0; bj < 2; ++bj) { const f32x4 v0 = acc[ai][bj][m][0] * s, v1 = acc[ai][bj][m][1] * s;
                    u32x4 w; w.x = pk2(v0[0], v0[1]); w.y = pk2(v0[2], v0[3]); w.z = pk2(v1[0], v1[1]); w.w = pk2(v1[2], v1[3]);
                    *(u32x4*)(Y + (size_t)row * ldy + col0 + bj * HALF) = w; } }
    }
};
struct EpiNull {
    static constexpr bool PERM = true, AFTER_DRAIN = false; static constexpr int NSTAT = 0; bf16_t* O;
    __device__ __forceinline__ void operator()(const f32x4 (&acc)[2][2][4][2], const Unit& u, int wr, int wc, int fr, int fq) const {
        float s = 0.f;
#pragma unroll
        for (int ai = 0; ai < 2; ++ai)
#pragma unroll
            for (int bj = 0; bj < 2; ++bj)
#pragma unroll
                for (int m = 0; m < 4; ++m)
#pragma unroll
                    for (int n = 0; n < 2; ++n) s += acc[ai][bj][m][n][0] + acc[ai][bj][m][n][1] + acc[ai][bj][m][n][2] + acc[ai][bj][m][n][3];
        if (s == 1.2345678e30f) O[u.pm * 256 + fr] = 1; }
};
}
__device__ __forceinline__ float gelu_tanh_f(float x) { const float u = 0.7978845608028654f * (x + 0.044715f * x * x * x); const float t = __builtin_amdgcn_exp2f(u * 2.8853900817779268f); return 0.5f * x * (2.f - 2.f * fast_rcp(1.f + t)); }

__device__ __forceinline__ void conv_phase(const Frame& F, int lp) {
    const bf16* XBR = (const bf16*)fact(F, FA_XBR); bf16* XC = (bf16*)fact(F, FA_XC); const float* cw = FIN(14) + lp * 4096; const float* cb = FIN(15) + lp * 1024;
    const int gt = (F.vcu * NWAVES + F.wave) * 64 + F.lane, NGT = F.G * NWAVES * 64;
    for (int it = gt; it < (TT / 16) * 128; it += NGT) {
        const int cg = it & 127, t0 = (it >> 7) * 16, c0 = cg * 8;
        float w[4][8], bsv[8];
#pragma unroll
        for (int j = 0; j < 4; ++j) { const f32x4 a = *(const f32x4*)(cw + j * 1024 + c0), b = *(const f32x4*)(cw + j * 1024 + c0 + 4); w[j][0] = a.x; w[j][1] = a.y; w[j][2] = a.z; w[j][3] = a.w; w[j][4] = b.x; w[j][5] = b.y; w[j][6] = b.z; w[j][7] = b.w; }
        { const f32x4 a = *(const f32x4*)(cb + c0), b = *(const f32x4*)(cb + c0 + 4); bsv[0] = a.x; bsv[1] = a.y; bsv[2] = a.z; bsv[3] = a.w; bsv[4] = b.x; bsv[5] = b.y; bsv[6] = b.z; bsv[7] = b.w; }
        float h0[8], h1[8], h2[8];
        const bool first = (t0 & (SEQL - 1)) == 0;
        auto ld = [&](int t, float (&o)[8]) { const v4u v = *(const GAS v4u*)(XBR + (size_t)t * DM + c0); o[0] = bflo(v.x); o[1] = bfhi(v.x); o[2] = bflo(v.y); o[3] = bfhi(v.y); o[4] = bflo(v.z); o[5] = bfhi(v.z); o[6] = bflo(v.w); o[7] = bfhi(v.w); };
        if (first) {
#pragma unroll
            for (int k = 0; k < 8; ++k) { h0[k] = 0.f; h1[k] = 0.f; h2[k] = 0.f; }
        } else { ld(t0 - 3, h0); ld(t0 - 2, h1); ld(t0 - 1, h2); }
#pragma unroll 4
        for (int i = 0; i < 16; ++i) { float cur[8]; ld(t0 + i, cur); float o[8];
#pragma unroll
            for (int k = 0; k < 8; ++k) { o[k] = bsv[k] + h0[k] * w[0][k] + h1[k] * w[1][k] + h2[k] * w[2][k] + cur[k] * w[3][k]; h0[k] = h1[k]; h1[k] = h2[k]; h2[k] = cur[k]; }
            v4u ov; ov.x = pk2(o[0], o[1]); ov.y = pk2(o[2], o[3]); ov.z = pk2(o[4], o[5]); ov.w = pk2(o[6], o[7]);
            *(GAS v4u*)(XC + (size_t)(t0 + i) * DM + c0) = ov; }
    }
}

__device__ __forceinline__ void conv_for_gates(const Frame& F, int lp) {
    const bf16* XBR = (const bf16*)fact(F, FA_XBR); bf16* XC = (bf16*)fact(F, FA_XC); const float* cw = FIN(14) + lp * 4096; const float* cb = FIN(15) + lp * 1024;
    for (int i = 0; i * F.G + (int)blockIdx.x < 512; i += 2) {
        const int L = (i + (F.tid >> 8)) * F.G + (int)blockIdx.x;
        if (L < 512) { const int pm = L >> 3, h = L & 7, task = F.tid & 255, cg = task & 15, tb = task >> 4, c0 = h * 128 + cg * 8, t0 = pm * 256 + tb * 16;
            float w[4][8], bsv[8];
#pragma unroll
            for (int j = 0; j < 4; ++j) { const f32x4 a = *(const f32x4*)(cw + j * 1024 + c0), b = *(const f32x4*)(cw + j * 1024 + c0 + 4); w[j][0] = a.x; w[j][1] = a.y; w[j][2] = a.z; w[j][3] = a.w; w[j][4] = b.x; w[j][5] = b.y; w[j][6] = b.z; w[j][7] = b.w; }
            { const f32x4 a = *(const f32x4*)(cb + c0), b = *(const f32x4*)(cb + c0 + 4); bsv[0] = a.x; bsv[1] = a.y; bsv[2] = a.z; bsv[3] = a.w; bsv[4] = b.x; bsv[5] = b.y; bsv[6] = b.z; bsv[7] = b.w; }
            const bool first = (t0 & (SEQL - 1)) == 0;
            v4u rows[19];
#pragma unroll
            for (int r = 0; r < 19; ++r) rows[r] = (first && r < 3) ? (v4u){0u, 0u, 0u, 0u} : *(const GAS v4u*)(XBR + (size_t)(t0 - 3 + r) * DM + c0);
            auto up = [&](const v4u v, float (&o)[8]) { o[0] = bflo(v.x); o[1] = bfhi(v.x); o[2] = bflo(v.y); o[3] = bfhi(v.y); o[4] = bflo(v.z); o[5] = bfhi(v.z); o[6] = bflo(v.w); o[7] = bfhi(v.w); };
            float h0[8], h1[8], h2[8];
            up(rows[0], h0); up(rows[1], h1); up(rows[2], h2);
#pragma unroll
            for (int r = 0; r < 16; ++r) { float cur[8]; up(rows[3 + r], cur); float o[8];
#pragma unroll
                for (int k = 0; k < 8; ++k) { o[k] = bsv[k] + h0[k] * w[0][k] + h1[k] * w[1][k] + h2[k] * w[2][k] + cur[k] * w[3][k]; h0[k] = h1[k]; h1[k] = h2[k]; h2[k] = cur[k]; }
                v4u ov; ov.x = pk2(o[0], o[1]); ov.y = pk2(o[2], o[3]); ov.z = pk2(o[4], o[5]); ov.w = pk2(o[6], o[7]);
                *(GAS v4u*)(XC + (size_t)(t0 + r) * DM + c0) = ov; } }
    }
    VM_WAIT(); __syncthreads();
}

__device__ __forceinline__ void scan_phase(const Frame& F, int lp) {
    const bf16* RA = (const bf16*)fact(F, FA_LA); const bf16* RI = (const bf16*)fact(F, FA_U); const bf16* XC = (const bf16*)fact(F, FA_XC); const bf16* G = (const bf16*)fact(F, FA_G); bf16* YG = (bf16*)fact(F, FA_YG);
    const float* coefp = (const float*)fact(F, FA_COEF) + lp * 1024;
    LAS float* sA = (LAS float*)(F.lds + RING_OFF); LAS float* sH = sA + 128 * 32; LAS float* sC = sH + 128 * 32; LAS float* gA = sC + 128 * 32; LAS float* gH = gA + 16 * 32; LAS float* gC = gH + 16 * 32; LAS float* sEnd = gC + 16 * 32;
    const int cg = F.tid & 3, chunk = F.tid >> 2, cl = cg * 8;
    for (int wg = blockIdx.x; wg < 8 * 32; wg += F.G) {
        const int b = wg >> 5, c0 = (wg & 31) * 32 + cl;
        float coef[8]; { const f32x4 x0 = *(const f32x4*)(coefp + c0), x1 = *(const f32x4*)(coefp + c0 + 4); coef[0] = x0[0]; coef[1] = x0[1]; coef[2] = x0[2]; coef[3] = x0[3]; coef[4] = x1[0]; coef[5] = x1[1]; coef[6] = x1[2]; coef[7] = x1[3]; }
        if (F.tid < 32) sEnd[F.tid] = 0.f;
        for (int half = 0; half < 2; ++half) {
            const size_t base = ((size_t)b * SEQL + half * 1024 + chunk * 8) * DM + c0;
            v4u lav[8], uv[8]; float ap[8], hh[8];
#pragma unroll
            for (int k = 0; k < 8; ++k) { ap[k] = 1.f; hh[k] = 0.f; }
            size_t off = base;
            v4u ra[8], ri[8], xc[8];
#pragma unroll
            for (int s0 = 0; s0 < 8; s0 += 2) {
                asm volatile("" : "+v"(off) :: "memory");
#pragma unroll
                for (int s = 0; s < 2; ++s) { const size_t o = off + (size_t)s * DM; ra[s0 + s] = *(const GAS v4u*)(RA + o); ri[s0 + s] = *(const GAS v4u*)(RI + o); xc[s0 + s] = *(const GAS v4u*)(XC + o); }
                off += 2 * DM; }
#pragma unroll
            for (int s = 0; s < 8; ++s) { unsigned lw[4], uw[4];
#pragma unroll
                    for (int q = 0; q < 4; ++q) { float l2[2], uu[2];
#pragma unroll
                        for (int e = 0; e < 2; ++e) { const unsigned wa = ra[s][q], wi = ri[s][q], wx = xc[s][q]; const float fa = e ? bfhi(wa) : bflo(wa), fi = e ? bfhi(wi) : bflo(wi), fx = e ? bfhi(wx) : bflo(wx);
                            const float r = sigm_f(fa), ig = sigm_f(fi); l2[e] = coef[2 * q + e] * r; uu[e] = ig * fx; }
                        const unsigned lp2 = pk2(l2[0], l2[1]);
#pragma unroll
                        for (int e = 0; e < 2; ++e) { const float lb = e ? bfhi(lp2) : bflo(lp2); const float z = lb * 1.3862943611198906f;
                            const float ser = -z * (1.f + z * (0.5f + z * (0.16666667f + z * 0.041666668f))), ex = 1.f - __builtin_amdgcn_exp2f(2.f * lb); const float om = (z > -0.1f) ? ser : ex;
                            uu[e] *= __builtin_amdgcn_sqrtf(fmaxf(om, 0.f)); }
                        const unsigned up2 = pk2(uu[0], uu[1]); lw[q] = lp2; uw[q] = up2;
#pragma unroll
                        for (int e = 0; e < 2; ++e) { const float a = __builtin_amdgcn_exp2f(e ? bfhi(lp2) : bflo(lp2)), ub = e ? bfhi(up2) : bflo(up2); hh[2 * q + e] = a * hh[2 * q + e] + ub; ap[2 * q + e] *= a; } }
                    lav[s] = (v4u){lw[0], lw[1], lw[2], lw[3]}; uv[s] = (v4u){uw[0], uw[1], uw[2], uw[3]}; }
            v4u gg[8];
            off = base;
#pragma unroll
            for (int s0 = 0; s0 < 8; s0 += 4) {
                asm volatile("" : "+v"(off) :: "memory");
#pragma unroll
                for (int s = 0; s < 4; ++s) gg[s0 + s] = *(const GAS v4u*)(G + off + (size_t)s * DM);
                off += 4 * DM; }
#pragma unroll
            for (int k = 0; k < 8; ++k) { sA[chunk * 32 + cl + k] = ap[k]; sH[chunk * 32 + cl + k] = hh[k]; }
            __syncthreads();
            { const int ch = F.tid & 31, grp = F.tid >> 5;
              float a = 1.f, h = 0.f;
              for (int i = 0; i < 8; ++i) { const int c = grp * 8 + i; const float ca = sA[c * 32 + ch], chh = sH[c * 32 + ch]; h = ca * h + chh; a *= ca; }
              gA[grp * 32 + ch] = a; gH[grp * 32 + ch] = h; }
            __syncthreads();
            if (F.tid < 32) { float c = sEnd[F.tid]; for (int g2 = 0; g2 < 16; ++g2) { gC[g2 * 32 + F.tid] = c; c = gA[g2 * 32 + F.tid] * c + gH[g2 * 32 + F.tid]; } sEnd[F.tid] = c; }
            __syncthreads();
            { const int ch = F.tid & 31, grp = F.tid >> 5; float c = gC[grp * 32 + ch];
              for (int i = 0; i < 8; ++i) { const int cc = grp * 8 + i; sC[cc * 32 + ch] = c; c = sA[cc * 32 + ch] * c + sH[cc * 32 + ch]; } }
            __syncthreads();
#pragma unroll
            for (int k = 0; k < 8; ++k) hh[k] = sC[chunk * 32 + cl + k];
            off = base;
#pragma unroll
            for (int s0 = 0; s0 < 8; s0 += 4) {
                asm volatile("" : "+v"(off) :: "memory");
#pragma unroll
                for (int s = 0; s < 4; ++s) { unsigned ow[4];
#pragma unroll
                    for (int q = 0; q < 4; ++q) { float y[2];
#pragma unroll
                        for (int e = 0; e < 2; ++e) { const unsigned lw = lav[s0 + s][q], uw = uv[s0 + s][q], gw = gg[s0 + s][q]; const float a = __builtin_amdgcn_exp2f(e ? bfhi(lw) : bflo(lw)), ub = e ? bfhi(uw) : bflo(uw);
                            hh[2 * q + e] = a * hh[2 * q + e] + ub; y[e] = hh[2 * q + e] * (e ? bfhi(gw) : bflo(gw)); }
                        ow[q] = pk2(y[0], y[1]); }
                    if (lru_out8(lp)) { int lo8 = 0, hi8 = 0;
                        lo8 = __builtin_amdgcn_cvt_pk_fp8_f32(bflo(ow[0]), bfhi(ow[0]), lo8, false); lo8 = __builtin_amdgcn_cvt_pk_fp8_f32(bflo(ow[1]), bfhi(ow[1]), lo8, true);
                        hi8 = __builtin_amdgcn_cvt_pk_fp8_f32(bflo(ow[2]), bfhi(ow[2]), hi8, false); hi8 = __builtin_amdgcn_cvt_pk_fp8_f32(bflo(ow[3]), bfhi(ow[3]), hi8, true);
                        *(GAS v2u*)((unsigned char*)YG + off + (size_t)s * DM) = (v2u){(unsigned)lo8, (unsigned)hi8}; }
                    else *(GAS v4u*)(YG + off + (size_t)s * DM) = (v4u){ow[0], ow[1], ow[2], ow[3]}; }
                off += 4 * DM;
            }
            __syncthreads();
        }
    }
}

namespace pg8 {
struct GateOrder {
    int G, c;
    __device__ __forceinline__ bool next(int i, Unit& u) const {
        const int L = i * G + c; if (L >= 512) return false;
        u.pm = L >> 3; u.pn = L & 7; u.aoff = (long)u.pm * (BM * 1024 * 2) + u.pn * 256; u.boff = (long)u.pn * (256 * WG_LD * 2); return true; }
    __device__ __forceinline__ void a_ready(const Unit&) const {}
    __device__ __forceinline__ void done(const Unit&) const {}
};
struct EpiLruIn {
    static constexpr bool PERM = true, AFTER_DRAIN = false; static constexpr int NSTAT = 2;
    bf16_t* Gt; bf16_t* XBR; const fx64* ssq; const float* bias; float accscale;
    __device__ __forceinline__ const void* tab_src(int k, const Unit& u) const { return k == 0 ? (const void*)(ssq + (size_t)u.pm * BM) : (const void*)(bias + u.pn * BM); }
    __device__ __forceinline__ int tab_bytes(int k) const { return k == 0 ? 2048 : 1024; }
    __device__ __forceinline__ void operator()(const f32x4 (&acc)[2][2][4][2], const Unit& u, int wr, int wc, int fr, int fq, const PG8_LAS unsigned char* tab) const {
        const int row0 = u.pm * BM + wr * 64 + fr, colg = u.pn * BM + wc * 32 + 8 * fq; const bool gate = u.pn < 4; bf16_t* O = gate ? Gt : XBR; const int col0 = colg & 1023;
        f32x4 bv[2][2];
#pragma unroll
        for (int bj = 0; bj < 2; ++bj)
#pragma unroll
            for (int n = 0; n < 2; ++n) bv[bj][n] = *(const PG8_LAS f32x4*)(tab + 2048 + (wc * 32 + 8 * fq + bj * HALF + 4 * n) * 4);
        float rsv[2][4];
#pragma unroll
        for (int ai = 0; ai < 2; ++ai)
#pragma unroll
            for (int m = 0; m < 4; ++m) rsv[ai][m] = fx_to(*(const PG8_LAS unsigned long long*)(tab + (wr * 64 + fr + ai * HALF + m * 16) * 8));
#pragma unroll
        for (int ai = 0; ai < 2; ++ai)
#pragma unroll
            for (int m = 0; m < 4; ++m) { const int row = row0 + ai * HALF + m * 16; const float rs = rstd_of(rsv[ai][m], 1.f / 1024.f) * accscale;
#pragma unroll
                for (int bj = 0; bj < 2; ++bj) { f32x4 v0 = acc[ai][bj][m][0] * rs + bv[bj][0], v1 = acc[ai][bj][m][1] * rs + bv[bj][1];
                    if (gate) {
                        float t8[8];
#pragma unroll
                        for (int j = 0; j < 4; ++j) { const float a = v0[j], b = v1[j]; t8[j] = a * __builtin_fmaf(a * a, -2.3022082f * 0.044715f, -2.3022082f); t8[4 + j] = b * __builtin_fmaf(b * b, -2.3022082f * 0.044715f, -2.3022082f); }
                        __builtin_amdgcn_sched_barrier(0);
#pragma unroll
                        for (int k = 0; k < 8; ++k) t8[k] = __builtin_amdgcn_exp2f(t8[k]);
                        __builtin_amdgcn_sched_barrier(0);
#pragma unroll
                        for (int k = 0; k < 8; ++k) t8[k] = t8[k] + 1.f;
                        __builtin_amdgcn_sched_barrier(0);
#pragma unroll
                        for (int k = 0; k < 8; ++k) t8[k] = __builtin_amdgcn_rcpf(t8[k]);
                        __builtin_amdgcn_sched_barrier(0);
#pragma unroll
                        for (int j = 0; j < 4; ++j) { v0[j] *= t8[j]; v1[j] *= t8[4 + j]; } }
                    u32x4 w; w.x = pk2(v0[0], v0[1]); w.y = pk2(v0[2], v0[3]); w.z = pk2(v1[0], v1[1]); w.w = pk2(v1[2], v1[3]);
                    *(u32x4*)(O + (size_t)row * DM + col0 + bj * HALF) = w; } }
    }
};
struct EpiGates {
    static constexpr bool PERM = true, AFTER_DRAIN = false; static constexpr int NSTAT = 2;
    bf16_t* RA; bf16_t* RI; const float* ba; const float* bi;
    __device__ __forceinline__ const void* tab_src(int k, const Unit& u) const { return (k == 0 ? ba : bi) + u.pn * 128; }
    __device__ __forceinline__ int tab_bytes(int) const { return 512; }
    __device__ __forceinline__ void operator()(const f32x4 (&acc)[2][2][4][2], const Unit& u, int wr, int wc, int fr, int fq, const PG8_LAS unsigned char* tab) const {
        const int row0 = u.pm * BM + wr * 64 + fr, ch0 = u.pn * 128 + wc * 32 + 8 * fq;
        const int cl = (wc * 32 + 8 * fq) * 4; const f32x4 a0 = *(const PG8_LAS f32x4*)(tab + cl), a1 = *(const PG8_LAS f32x4*)(tab + cl + 16), b0 = *(const PG8_LAS f32x4*)(tab + 2048 + cl), b1 = *(const PG8_LAS f32x4*)(tab + 2048 + cl + 16);
#pragma unroll
        for (int ai = 0; ai < 2; ++ai)
#pragma unroll
            for (int m = 0; m < 4; ++m) { const int row = row0 + ai * HALF + m * 16;
                { const f32x4 v0 = acc[ai][0][m][0] + a0, v1 = acc[ai][0][m][1] + a1; u32x4 w; w.x = pk2(v0[0], v0[1]); w.y = pk2(v0[2], v0[3]); w.z = pk2(v1[0], v1[1]); w.w = pk2(v1[2], v1[3]); *(u32x4*)(RA + (size_t)row * DM + ch0) = w; }
                { const f32x4 v0 = acc[ai][1][m][0] + b0, v1 = acc[ai][1][m][1] + b1; u32x4 w; w.x = pk2(v0[0], v0[1]); w.y = pk2(v0[2], v0[3]); w.z = pk2(v1[0], v1[1]); w.w = pk2(v1[2], v1[3]); *(u32x4*)(RI + (size_t)row * DM + ch0) = w; } }
    }
};
}
constexpr int KIMG = 24576, VIMG = 16384;
__device__ __forceinline__ int v_st(int k, int c) { const int kk = (k & ~0xC) | ((k & 4) << 1) | ((k & 8) >> 1); return ((kk >> 3) * 4 + (c >> 5)) * 512 + ((kk & 7) * 32 + (c & 31)) * 2; }
__device__ __forceinline__ int v_rd_base(int lane) { return ((lane & 3) << 3) | (((lane >> 2) & 3) << 6) | (((lane >> 4) & 1) << 5) | (((lane >> 5) & 1) << 8); }
constexpr int v_rd_off(int d0, int ks, int half) { return d0 * 512 + ks * 4096 + half * 2048; }

namespace pg8 {
struct EpiMlaIn {
    static constexpr bool PERM = true, AFTER_DRAIN = false; static constexpr int NSTAT = 1;
    bf16_t* CQ; bf16_t* CKV; float* KR; const fx64* ssq; fx64* ssq_cq; fx64* ssq_ckv; fx64* ssq_kr; const float* gkn; const float* cs;
    __device__ __forceinline__ const void* tab_src(int, const Unit& u) const { return ssq + (size_t)u.pm * BM; }
    __device__ __forceinline__ int tab_bytes(int) const { return 2048; }
    __device__ __forceinline__ void operator()(const f32x4 (&acc)[2][2][4][2], const Unit& u, int wr, int wc, int fr, int fq, const PG8_LAS unsigned char* tab) const {
        const int row0 = u.pm * BM + wr * 64 + fr;
        float rsv[2][4];
#pragma unroll
        for (int ai = 0; ai < 2; ++ai)
#pragma unroll
            for (int m = 0; m < 4; ++m) rsv[ai][m] = fx_to(*(const PG8_LAS unsigned long long*)(tab + (wr * 64 + fr + ai * HALF + m * 16) * 8));
#pragma unroll
        for (int bj = 0; bj < 2; ++bj) {
            const int seg = u.pn * 2 + bj;
            if (seg < 5) {
                bf16_t* O = seg < 3 ? CQ : CKV; const int ld = seg < 3 ? CQ_LD : CKV_LD; const int col0 = (seg < 3 ? seg : seg - 3) * 128 + wc * 32 + 8 * fq; fx64* sq = seg < 3 ? ssq_cq : ssq_ckv;
#pragma unroll
                for (int ai = 0; ai < 2; ++ai)
#pragma unroll
                    for (int m = 0; m < 4; ++m) { const int row = row0 + ai * HALF + m * 16; const float rs = rstd_of(rsv[ai][m], 1.f / 1024.f);
                        const f32x4 v0 = acc[ai][bj][m][0] * rs, v1 = acc[ai][bj][m][1] * rs;
                        float s = (v0[0] * v0[0] + v0[1] * v0[1]) + (v0[2] * v0[2] + v0[3] * v0[3]) + (v1[0] * v1[0] + v1[1] * v1[1]) + (v1[2] * v1[2] + v1[3] * v1[3]);
                        u32x4 w; w.x = pk2(v0[0], v0[1]); w.y = pk2(v0[2], v0[3]); w.z = pk2(v1[0], v1[1]); w.w = pk2(v1[2], v1[3]);
                        *(u32x4*)(O + (size_t)row * ld + col0) = w;
                        { const int ln_ = fq * 16 + fr; s += xshfl(s, 16, ln_); s += xshfl(s, 32, ln_); } if (fq == 0) fx_add(sq + row, s); }
            } else if (wc < 2) {
                const int idx0 = 16 * wc + 4 * fq; const f32x4 g1 = *(const f32x4*)(gkn + 128 + idx0), g2 = *(const f32x4*)(gkn + 160 + idx0);
                f32x4 cv[2][4], sv[2][4];
#pragma unroll
                for (int ai = 0; ai < 2; ++ai)
#pragma unroll
                    for (int m = 0; m < 4; ++m) { const size_t ro = (size_t)(row0 + ai * HALF + m * 16) * 32 + idx0; cv[ai][m] = *(const f32x4*)(cs + ro); sv[ai][m] = *(const f32x4*)(cs + (size_t)TT * 32 + ro); }
#pragma unroll
                for (int ai = 0; ai < 2; ++ai)
#pragma unroll
                    for (int m = 0; m < 4; ++m) { const int row = row0 + ai * HALF + m * 16; const float rs = rstd_of(rsv[ai][m], 1.f / 1024.f);
                        const f32x4 x1 = acc[ai][bj][m][0] * rs, x2 = acc[ai][bj][m][1] * rs;
                        float s = (x1[0] * x1[0] + x1[1] * x1[1]) + (x1[2] * x1[2] + x1[3] * x1[3]) + (x2[0] * x2[0] + x2[1] * x2[1]) + (x2[2] * x2[2] + x2[3] * x2[3]);
                        const f32x4 c = cv[ai][m], sn = sv[ai][m];
                        const f32x4 a = x1 * g1, b = x2 * g2; const f32x4 y1 = a * c - b * sn, y2 = a * sn + b * c;
                        *(f32x4*)(KR + (size_t)row * 64 + idx0) = y1; *(f32x4*)(KR + (size_t)row * 64 + 32 + idx0) = y2;
                        { const int ln_ = fq * 16 + fr; s += xshfl(s, 16, ln_); s += xshfl(s, 32, ln_); } if (fq == 0) fx_add(ssq_kr + row, s); }
            }
        }
    }
};
struct EpiKV {
    static constexpr bool PERM = true, AFTER_DRAIN = false; static constexpr int NSTAT = 2;
    unsigned char* Kimg; unsigned char* Vimg; const float* KR; const fx64* ssq_ckv; const fx64* ssq_kr; const float* gkn; PG8_LAS float* xch;
    __device__ __forceinline__ const void* tab_src(int k, const Unit& u) const { return (k == 0 ? ssq_ckv : ssq_kr) + (size_t)u.pm * BM; }
    __device__ __forceinline__ int tab_bytes(int) const { return 2048; }
    __device__ __forceinline__ void operator()(const f32x4 (&acc)[2][2][4][2], const Unit& u, int wr, int wc, int fr, int fq, const PG8_LAS unsigned char* tab) const {
        const int rl0 = wr * 64 + fr, row0 = u.pm * BM + rl0, h = u.pn;
        const int c0 = wc * 32 + 8 * fq; const f32x4 g0 = *(const f32x4*)(gkn + c0), g1 = *(const f32x4*)(gkn + c0 + 4);
        f32x4 krv[2][4];
#pragma unroll
        for (int ai = 0; ai < 2; ++ai)
#pragma unroll
            for (int m = 0; m < 4; ++m) krv[ai][m] = *(const f32x4*)(KR + (size_t)(row0 + ai * HALF + m * 16) * 64 + 16 * wc + 4 * fq);
        float rsv[2][4], skr[2][4];
#pragma unroll
        for (int ai = 0; ai < 2; ++ai)
#pragma unroll
            for (int m = 0; m < 4; ++m) { rsv[ai][m] = fx_to(*(const PG8_LAS unsigned long long*)(tab + (rl0 + ai * HALF + m * 16) * 8)); skr[ai][m] = fx_to(*(const PG8_LAS unsigned long long*)(tab + 2048 + (rl0 + ai * HALF + m * 16) * 8)); }
#pragma unroll
        for (int ai = 0; ai < 2; ++ai)
#pragma unroll
            for (int m = 0; m < 4; ++m) { const float rs = rstd_of(rsv[ai][m], 1.f / 256.f); rsv[ai][m] = rs; const f32x4 v0 = acc[ai][0][m][0] * rs, v1 = acc[ai][0][m][1] * rs;
                float s = (v0[0] * v0[0] + v0[1] * v0[1]) + (v0[2] * v0[2] + v0[3] * v0[3]) + (v1[0] * v1[0] + v1[1] * v1[1]) + (v1[2] * v1[2] + v1[3] * v1[3]);
                { const int ln_ = fq * 16 + fr; s += xshfl(s, 16, ln_); s += xshfl(s, 32, ln_); } if (fq == 0) xch[(rl0 + ai * HALF + m * 16) * 4 + wc] = s; }
        asm volatile("s_waitcnt lgkmcnt(0)" ::: "memory"); __builtin_amdgcn_s_barrier(); asm volatile("" ::: "memory");
        const int b = (u.pm * BM) >> 11;
#pragma unroll
        for (int ai = 0; ai < 2; ++ai)
#pragma unroll
            for (int m = 0; m < 4; ++m) { const int rl = rl0 + ai * HALF + m * 16, row = u.pm * BM + rl; const f32x4 pp = *(const PG8_LAS f32x4*)(xch + rl * 4);
                const float rk = rstd_of((pp[0] + pp[1]) + (pp[2] + pp[3]) + skr[ai][m], 1.f / 192.f); const float rs = rsv[ai][m];
                const int ts = row & 2047, tile = ts >> 6, key = ts & 63; const size_t ibase = ((size_t)(b * 8 + h) * 32 + tile);
                unsigned char* kb = Kimg + ibase * KIMG + key * 16; unsigned char* vb = Vimg + ibase * VIMG;
                { const f32x4 v0 = acc[ai][0][m][0] * (rs * rk) * g0, v1 = acc[ai][0][m][1] * (rs * rk) * g1;
                  u32x4 w; w.x = pk2(v0[0], v0[1]); w.y = pk2(v0[2], v0[3]); w.z = pk2(v1[0], v1[1]); w.w = pk2(v1[2], v1[3]);
                  *(u32x4*)(kb + (4 * wc + fq) * 1024) = w; }
                { const f32x4 kr = krv[ai][m] * rk; v2u w; w.x = pk2(kr[0], kr[1]); w.y = pk2(kr[2], kr[3]);
                  *(v2u*)(kb + (16 + 2 * wc + (fq >> 1)) * 1024 + (fq & 1) * 8) = w; }
                { const f32x4 v0 = acc[ai][1][m][0] * rs, v1 = acc[ai][1][m][1] * rs;
                  u32x4 w; w.x = pk2(v0[0], v0[1]); w.y = pk2(v0[2], v0[3]); w.z = pk2(v1[0], v1[1]); w.w = pk2(v1[2], v1[3]);
                  *(u32x4*)(vb + v_st(key, c0)) = w; } }
    }
};
struct EpiRstdBf16 {
    static constexpr bool PERM = true, AFTER_DRAIN = false; static constexpr int NSTAT = 1;
    bf16_t* O; int ldo; const fx64* ssq; float invn;
    __device__ __forceinline__ const void* tab_src(int, const Unit& u) const { return ssq + (size_t)u.pm * BM; }
    __device__ __forceinline__ int tab_bytes(int) const { return 2048; }
    __device__ __forceinline__ void operator()(const f32x4 (&acc)[2][2][4][2], const Unit& u, int wr, int wc, int fr, int fq, const PG8_LAS unsigned char* tab) const {
        const int row0 = u.pm * BM + wr * 64 + fr, col0 = u.pn * BM + wc * 32 + 8 * fq;
        float sc[2][4];
#pragma unroll
        for (int ai = 0; ai < 2; ++ai)
#pragma unroll
            for (int m = 0; m < 4; ++m) sc[ai][m] = fx_to(*(const PG8_LAS unsigned long long*)(tab + (wr * 64 + fr + ai * HALF + m * 16) * 8));
#pragma unroll
        for (int ai = 0; ai < 2; ++ai)
#pragma unroll
            for (int m = 0; m < 4; ++m) { const int row = row0 + ai * HALF + m * 16; const float s = rstd_of(sc[ai][m], invn);
#pragma unroll
                for (int bj = 0; bj < 2; ++bj) { const f32x4 v0 = acc[ai][bj][m][0] * s, v1 = acc[ai][bj][m][1] * s;
                    u32x4 w; w.x = pk2(v0[0], v0[1]); w.y = pk2(v0[2], v0[3]); w.z = pk2(v1[0], v1[1]); w.w = pk2(v1[2], v1[3]);
                    *(u32x4*)(O + (size_t)row * ldo + col0 + bj * HALF) = w; } }
    }
};
}

namespace att {
using f32x16 = __attribute__((ext_vector_type(16))) float;
using s16x4 = __attribute__((ext_vector_type(4))) short;
constexpr int SLOTB = KIMG + VIMG, NSLOT = 3;
static_assert(NSLOT * SLOTB <= RING_BYTES, "attention ring");
constexpr float C2 = 0.07216878364870322f * 1.4426950408889634f;
constexpr float THR2 = 8.f;
__device__ __forceinline__ int crow(int r, int hi) { return (r & 3) + 8 * (r >> 2) + 4 * hi; }
__device__ __forceinline__ void glds16(const void* gsrc, unsigned lds_dst) { unsigned keep;
    asm volatile("s_mov_b32 %0, m0\n\ts_mov_b32 m0, %2\n\ts_nop 0\n\tglobal_load_lds_dwordx4 %1, off\n\ts_mov_b32 m0, %0" : "=&s"(keep) : "v"(gsrc), "s"(lds_dst) : "memory"); }
template <int OFF> __device__ __forceinline__ s16x4 tr_read(int vb) { s16x4 r; asm volatile("ds_read_b64_tr_b16 %0, %1 offset:%2" : "=&v"(r) : "v"(vb), "i"(OFF) : "memory"); return r; }
template <int D0> __device__ __forceinline__ void pv_one(f32x16& od, int vb, bf16x8 pa0, bf16x8 pa1, bf16x8 pa2, bf16x8 pa3) {
    const s16x4 l0 = tr_read<v_rd_off(D0, 0, 0)>(vb), h0 = tr_read<v_rd_off(D0, 0, 1)>(vb), l1 = tr_read<v_rd_off(D0, 1, 0)>(vb), h1 = tr_read<v_rd_off(D0, 1, 1)>(vb);
    const s16x4 l2 = tr_read<v_rd_off(D0, 2, 0)>(vb), h2 = tr_read<v_rd_off(D0, 2, 1)>(vb), l3 = tr_read<v_rd_off(D0, 3, 0)>(vb), h3 = tr_read<v_rd_off(D0, 3, 1)>(vb);
    asm volatile("s_waitcnt lgkmcnt(0)" ::: "memory"); __builtin_amdgcn_sched_barrier(0);
#define ATT_PK(L, H) (bf16x8){L[0], L[1], L[2], L[3], H[0], H[1], H[2], H[3]}
    od = __builtin_amdgcn_mfma_f32_32x32x16_bf16(pa0, ATT_PK(l0, h0), od, 0, 0, 0);
    od = __builtin_amdgcn_mfma_f32_32x32x16_bf16(pa1, ATT_PK(l1, h1), od, 0, 0, 0);
    od = __builtin_amdgcn_mfma_f32_32x32x16_bf16(pa2, ATT_PK(l2, h2), od, 0, 0, 0);
    od = __builtin_amdgcn_mfma_f32_32x32x16_bf16(pa3, ATT_PK(l3, h3), od, 0, 0, 0);
#undef ATT_PK
}
__device__ __forceinline__ void attn_unit(const Frame& F, int lp, int b, int h, int qb) {
    const int lane = F.lane, r32 = lane & 31, hi = lane >> 5, wid = F.wave;
    const bf16* Q = (const bf16*)fact(F, FA_Q); bf16* O = (bf16*)fact(F, FA_O); const float* cs = (const float*)fact(F, FA_ROPE); const float* gqn = FIN(9) + lp * 192;
    const unsigned char* Kimg = fact(F, FA_K) + (size_t)(b * 8 + h) * 32 * KIMG; const unsigned char* Vimg = fact(F, FA_V) + (size_t)(b * 8 + h) * 32 * VIMG;
    LAS unsigned char* ring = F.lds + RING_OFF; const unsigned ring0 = (unsigned)(uintptr_t)ring;
    LAS float* wsf = (LAS float*)(F.lds + XCH_OFF) + wid * 64;
    const int t0 = b * SEQL + qb * 256 + wid * 32, row = t0 + r32;
    bf16x8 qr[12];
    { const bf16* qp = Q + (size_t)row * 1536 + h * 192 + 8 * hi; v4u raw[12]; float s = 0.f;
#pragma unroll
      for (int d0 = 0; d0 < 12; ++d0) raw[d0] = *(const GAS v4u*)(qp + 16 * d0);
#pragma unroll
      for (int d0 = 0; d0 < 12; ++d0) { const v4u v = raw[d0]; const float a0 = bflo(v.x), a1 = bfhi(v.x), a2 = bflo(v.y), a3 = bfhi(v.y), a4 = bflo(v.z), a5 = bfhi(v.z), a6 = bflo(v.w), a7 = bfhi(v.w);
          s += (a0 * a0 + a1 * a1) + (a2 * a2 + a3 * a3) + (a4 * a4 + a5 * a5) + (a6 * a6 + a7 * a7); }
      s += xshfl(s, 32, lane); const float rq = rstd_of(s, 1.f / 192.f) * C2;
      auto unpack = [&](const v4u v, const float* gp, float (&o)[8]) { const f32x4 g0 = *(const f32x4*)gp, g1 = *(const f32x4*)(gp + 4);
          o[0] = bflo(v.x) * rq * g0[0]; o[1] = bfhi(v.x) * rq * g0[1]; o[2] = bflo(v.y) * rq * g0[2]; o[3] = bfhi(v.y) * rq * g0[3]; o[4] = bflo(v.z) * rq * g1[0]; o[5] = bfhi(v.z) * rq * g1[1]; o[6] = bflo(v.w) * rq * g1[2]; o[7] = bfhi(v.w) * rq * g1[3]; };
      auto pack = [&](const float (&o)[8]) { v4u w; w.x = pk2(o[0], o[1]); w.y = pk2(o[2], o[3]); w.z = pk2(o[4], o[5]); w.w = pk2(o[6], o[7]); return __builtin_bit_cast(bf16x8, w); };
#pragma unroll
      for (int d0 = 0; d0 < 8; ++d0) { float o[8]; unpack(raw[d0], gqn + 16 * d0 + 8 * hi, o); qr[d0] = pack(o); asm volatile("" : "+v"(qr[d0])); }
#pragma unroll
      for (int d0 = 8; d0 < 10; ++d0) { float x1[8], x2[8]; unpack(raw[d0], gqn + 16 * d0 + 8 * hi, x1); unpack(raw[d0 + 2], gqn + 16 * (d0 + 2) + 8 * hi, x2);
          const float* cp = cs + (size_t)row * 32 + 16 * (d0 - 8) + 8 * hi; const f32x4 c0 = *(const f32x4*)cp, c1 = *(const f32x4*)(cp + 4), s0 = *(const f32x4*)(cp + (size_t)TT * 32), s1 = *(const f32x4*)(cp + (size_t)TT * 32 + 4);
          float y1[8], y2[8];
#pragma unroll
          for (int j = 0; j < 8; ++j) { const float c = j < 4 ? c0[j] : c1[j - 4], sn = j < 4 ? s0[j] : s1[j - 4]; y1[j] = x1[j] * c - x2[j] * sn; y2[j] = x1[j] * sn + x2[j] * c; }
          qr[d0] = pack(y1); qr[d0 + 2] = pack(y2); asm volatile("" : "+v"(qr[d0]), "+v"(qr[d0 + 2])); } }
    const int ntb = 4 * qb + 4, my_nt = 4 * qb + (wid >> 1) + 1;
#define ATT_ISSUE(t, slot) do { _Pragma("unroll") for (int i_ = 0; i_ < 5; ++i_) { const int p_ = wid + 8 * i_; \
        const unsigned char* src_ = (p_ < 24) ? (Kimg + (size_t)(t) * KIMG + p_ * 1024) : (Vimg + (size_t)(t) * VIMG + (p_ - 24) * 1024); \
        glds16(src_ + lane * 16, (unsigned)__builtin_amdgcn_readfirstlane(ring0 + (slot) * SLOTB + p_ * 1024)); } } while (0)
    ATT_ISSUE(0, 0); ATT_ISSUE(1, 1);
    float m_reg = -1e30f, l_reg = 0.f; f32x16 o[4];
#pragma unroll
    for (int d = 0; d < 4; ++d) o[d] = f32x16{};
    int slot = 0;
    for (int t = 0; t < ntb; ++t) {
        if (t + 1 < ntb) asm volatile("s_waitcnt vmcnt(5)" ::: "memory"); else asm volatile("s_waitcnt vmcnt(0)" ::: "memory");
        asm volatile("s_waitcnt lgkmcnt(0)\n\ts_barrier" ::: "memory");
        if (t + 2 < ntb) { const int s2 = (slot + 2 >= NSLOT) ? slot + 2 - NSLOT : slot + 2; ATT_ISSUE(t + 2, s2); }
        if (t < my_nt) {
            const LAS unsigned char* Ks = ring + slot * SLOTB; const int vb = (int)(ring0 + slot * SLOTB + KIMG) + v_rd_base(lane);
            f32x16 p0 = f32x16{}, p1 = f32x16{};
#pragma unroll
            for (int d0 = 0; d0 < 12; ++d0) { const bf16x8 k0 = *(const LAS bf16x8*)(Ks + (2 * d0 + hi) * 1024 + r32 * 16), k1 = *(const LAS bf16x8*)(Ks + (2 * d0 + hi) * 1024 + 512 + r32 * 16);
                p0 = __builtin_amdgcn_mfma_f32_32x32x16_bf16(k0, qr[d0], p0, 0, 0, 0); p1 = __builtin_amdgcn_mfma_f32_32x32x16_bf16(k1, qr[d0], p1, 0, 0, 0); }
            float pmax = p0[0];
#pragma unroll
            for (int r = 1; r < 16; ++r) pmax = fmaxf(pmax, p0[r]);
#pragma unroll
            for (int r = 0; r < 16; ++r) pmax = fmaxf(pmax, p1[r]);
            { auto rr = __builtin_amdgcn_permlane32_swap(__float_as_uint(pmax), __float_as_uint(pmax), false, false); pmax = fmaxf(__uint_as_float(rr[0]), __uint_as_float(rr[1])); }
            float alpha = 1.f;
            if (!__all(pmax - m_reg <= THR2)) { const float mn = fmaxf(m_reg, pmax); alpha = __builtin_amdgcn_exp2f(m_reg - mn); m_reg = mn; }
            float ps = 0.f;
#pragma unroll
            for (int r = 0; r < 16; ++r) { p0[r] = __builtin_amdgcn_exp2f(p0[r] - m_reg); p1[r] = __builtin_amdgcn_exp2f(p1[r] - m_reg); ps += p0[r] + p1[r]; }
            { auto rr = __builtin_amdgcn_permlane32_swap(__float_as_uint(ps), __float_as_uint(ps), false, false); ps = __uint_as_float(rr[0]) + __uint_as_float(rr[1]); }
            l_reg = l_reg * alpha + ps;
            if (__any(alpha < 1.f)) { if (hi == 0) wsf[r32] = alpha; asm volatile("s_waitcnt lgkmcnt(0)" ::: "memory");
#pragma unroll
                for (int r = 0; r < 16; ++r) { const float a = wsf[crow(r, hi)];
#pragma unroll
                    for (int d = 0; d < 4; ++d) o[d][r] *= a; } }
            bf16x8 pa0, pa1, pa2, pa3;
#define ATT_PK4(P, BASE, OUT) do { unsigned a0 = pk2(P[BASE + 0], P[BASE + 1]), a1 = pk2(P[BASE + 2], P[BASE + 3]), b0 = pk2(P[BASE + 4], P[BASE + 5]), b1 = pk2(P[BASE + 6], P[BASE + 7]); \
        auto r0 = __builtin_amdgcn_permlane32_swap(a0, b0, false, false); auto r1 = __builtin_amdgcn_permlane32_swap(a1, b1, false, false); \
        v4u w_ = {r0[0], r1[0], r0[1], r1[1]}; OUT = __builtin_bit_cast(bf16x8, w_); } while (0)
            ATT_PK4(p0, 0, pa0); ATT_PK4(p0, 8, pa1); ATT_PK4(p1, 0, pa2); ATT_PK4(p1, 8, pa3);
#undef ATT_PK4
            pv_one<0>(o[0], vb, pa0, pa1, pa2, pa3); pv_one<1>(o[1], vb, pa0, pa1, pa2, pa3); pv_one<2>(o[2], vb, pa0, pa1, pa2, pa3); pv_one<3>(o[3], vb, pa0, pa1, pa2, pa3);
        }
        slot = (slot + 1 >= NSLOT) ? 0 : slot + 1;
    }
#undef ATT_ISSUE
    if (hi == 0) wsf[32 + r32] = l_reg;
    asm volatile("s_waitcnt lgkmcnt(0)\n\ts_barrier" ::: "memory");
    { LAS bf16* stg = (LAS bf16*)(ring + wid * 8704);
#pragma unroll
      for (int r = 0; r < 16; ++r) { const int orow = crow(r, hi); const float il = fast_rcp(wsf[32 + orow]);
#pragma unroll
          for (int d = 0; d < 4; ++d) stg[orow * 136 + 32 * d + r32] = (bf16)f2bf(o[d][r] * il); }
      asm volatile("s_waitcnt lgkmcnt(0)" ::: "memory");
      bf16* Ob = O + (size_t)t0 * DM + h * 128;
#pragma unroll
      for (int i = 0; i < 8; ++i) { const int p = lane + 64 * i, orow = p >> 4, c = p & 15; const v4u v = *(const LAS v4u*)(stg + orow * 136 + 8 * c); *(GAS v4u*)(Ob + (size_t)orow * DM + 8 * c) = v; } }
    asm volatile("s_waitcnt lgkmcnt(0)\n\ts_barrier" ::: "memory");
}
__device__ __forceinline__ void attn_phase(const Frame& F, int lp) {
    for (int v = F.vcu; v < 256; v += F.G) { const int bh = v >> 2, s = v & 3; attn_unit(F, lp, bh >> 3, bh & 7, s); attn_unit(F, lp, bh >> 3, bh & 7, 7 - s); }
}
}
#ifndef PROBE_DBG
#define PROBE_DBG 0
#endif
struct Args { const float* in[31]; float* out; unsigned char* ws; int ph_lo, ph_hi; };
enum { PH_M1 = 0, PH_M2, PH_ATT, PH_WO, PH_FU, PH_FD, PH_L1, PH_L2, PH_L3, PH_L4, PH_L5, PH_R1, PH_R2, PH_MU, PH_MD, PH_CB, PH_PER_PAIR = 20 };
constexpr int PH_PREP = 100;
constexpr int PH_END = 1 + PH_PER_PAIR + PH_CB + 1;

__global__ void __launch_bounds__(NWAVES * 64, 2) mega(Args args) {
    extern __shared__ __attribute__((aligned(16))) unsigned char lds[];
    Frame F;
    F.lds = (LAS unsigned char*)lds; F.MISC = (volatile LAS unsigned*)(F.lds + MISC_OFF);
    F.tid = threadIdx.x; F.lane = F.tid & 63; F.wave = __builtin_amdgcn_readfirstlane(F.tid >> 6);
    F.G = gridDim.x; { const int bx = blockIdx.x; F.vcu = (F.G % 8 == 0) ? (bx % 8) * (F.G / 8) + bx / 8 : bx; }
    F.in = args.in; F.X = args.out; F.ws = args.ws; F.ctl = (gu32*)(args.ws + WS_CTL);
    for (int u = F.tid; u < (LDS_BYTES - LDSCTL_OFF) / 4; u += NWAVES * 64) ((LAS unsigned*)(F.lds + LDSCTL_OFF))[u] = 0u;
    __syncthreads();
    const int lo = args.ph_lo, hi = args.ph_hi;
    const bool multi = (hi - lo) > 1 && lo < PH_PREP;
    XcdBarrier bar; bar.bar = (unsigned*)(F.ctl + CW_BAR); bar.x = 0; bar.st = nullptr;
    if (multi) bar = xcd_barrier_post((unsigned*)(F.ctl + CW_BAR), F.MISC + 8, F.tid == 0);
#define IN(k) (lo <= (k) && (k) < hi)
#define PIN(k) (P.in[k])
#define OPAQUE_FRAME(P) Frame P = F; asm volatile("v_mbcnt_lo_u32_b32 %0, -1, 0\n\tv_mbcnt_hi_u32_b32 %0, -1, %0" : "=v"(P.lane)); P.tid = P.wave * 64 + P.lane; \
    { int z_; asm volatile("v_mov_b32 %0, 0" : "=v"(z_)); z_ = __builtin_amdgcn_readfirstlane(z_); P.ws += z_; P.X += z_; P.in += z_; } P.ctl = (gu32*)(P.ws + WS_CTL)
#define SEAM(k) do { if (IN((k) + 1) && multi) { int l_; asm volatile("v_mbcnt_lo_u32_b32 %0, -1, 0\n\tv_mbcnt_hi_u32_b32 %0, -1, %0" : "=v"(l_)); XcdBarrier b2_ = bar; { int z_; asm volatile("v_mov_b32 %0, 0" : "=v"(z_)); b2_.bar += __builtin_amdgcn_readfirstlane(z_); } xcd_barrier(b2_, F.wave == 0 && l_ == 0); } } while (0)
    LAS unsigned char* ring = F.lds + RING_OFF;

    if (IN(0)) { OPAQUE_FRAME(P); p0_prologue(P, 0, 2 * JOBS_PER_PAIR); SEAM(0); }
#ifdef PROBE_EXTRA
    if (lo == 201 || lo == 202 || lo == 203) { OPAQUE_FRAME(P); bf16* XB = (bf16*)fact(P, FA_XB); const int pit = lo == 203 ? 1088 : 1024;
        pg8::Gemm g{XB, wt(P, 1, WO_W13), pit, pit, 1024}; pg8::StaticOrder S; S.init(TT, 5632, P.G, (int)blockIdx.x, pit, pit);
        if (lo != 202) { pg8::EpiNull E{(bf16*)fact(P, FA_H)}; pg8::gemm_phase<pg8::EpiNull, pg8::StaticOrder, true, true>(ring, g, S, E, P.wave); }
        else { pg8::EpiScaleBf16 E{(bf16*)fact(P, FA_H), 2816, (const float*)fact(P, FA_SLOT + SL_GATE), 11, 1.f}; pg8::gemm_phase<pg8::EpiScaleBf16, pg8::StaticOrder, true, true>(ring, g, S, E, P.wave); }
        return; }
#endif
#ifdef PROBE_EXTRA
    if ((lo >= 204 && lo <= 209) || lo == 230) { OPAQUE_FRAME(P); const int lp = 1; const int pit = lo == 230 ? 512 : MOE8_PITCH / 2;
        const MoeSeg sg = moe_segments(P, lp); int kz_; asm volatile("v_mov_b32 %0, 0" : "=v"(kz_)); kz_ = __builtin_amdgcn_readfirstlane(kz_);
        pg8::Gemm g{(bf16*)fact(P, FA_AS), wt(P, lp, WO_M13), pit, pit, (lo == 208 ? 256 : (lo == 209 ? 128 : 512)) + kz_, 127, 127}; pg8::MoeOrder S; S.init(sg, 28, P.G, (int)blockIdx.x, pit, pit); S.probe_same = lo >= 208 ? 0 : lo - 204;
        pg8::EpiNull E{(bf16*)fact(P, FA_MH)};
        pg8::gemm_phase<pg8::EpiNull, pg8::MoeOrder, true, true, 1, PROBE_DBG>(ring, g, S, E, P.wave); return; }
#endif
#ifdef PROBE_EXTRA
    if ((lo >= 221 && lo <= 229) || (lo >= 232 && lo <= 235)) { OPAQUE_FRAME(P); const int lp = 1; bf16* XB = (bf16*)fact(P, FA_XB);
        int kz_; asm volatile("v_mov_b32 %0, 0" : "=v"(kz_)); kz_ = __builtin_amdgcn_readfirstlane(kz_);
        pg8::EpiNull EN{(bf16*)fact(P, FA_MH)};
        if (lo == 221 || lo == 222) { pg8::Gemm g{(bf16*)fact(P, FA_CKV), wt(P, lp, WO_WKVB), CKV_LD, CKV_LD, 256 + kz_}; pg8::StaticOrder S; S.init(TT, 2048, P.G, (int)blockIdx.x, CKV_LD, CKV_LD);
            pg8::EpiKV E{fact(P, FA_K), fact(P, FA_V), (const float*)fact(P, FA_KR), ssq_arr(P, 9 + 3 * lp), ssq_arr(P, 10 + 3 * lp), PIN(10) + lp * 192, (LAS float*)(P.lds + XCH_OFF)};
            if (lo == 221) pg8::gemm_phase<pg8::EpiKV, pg8::StaticOrder, true, true>(ring, g, S, E, P.wave); else pg8::gemm_phase<pg8::EpiNull, pg8::StaticOrder, true, true, 0, PROBE_DBG>(ring, g, S, EN, P.wave); }
        else if (lo == 223 || lo == 224) { pg8::Gemm g{(bf16*)fact(P, FA_CQ), wt(P, lp, WO_WQB), CQ_LD, CQ_LD, 384 + kz_}; pg8::StaticOrder S; S.init(TT, 1536, P.G, (int)blockIdx.x, CQ_LD, CQ_LD);
            pg8::EpiRstdBf16 E{(bf16*)fact(P, FA_Q), 1536, ssq_arr(P, 8 + 3 * lp), 1.f / 384.f};
            if (lo == 223) pg8::gemm_phase<pg8::EpiRstdBf16, pg8::StaticOrder, true, true>(ring, g, S, E, P.wave); else pg8::gemm_phase<pg8::EpiNull, pg8::StaticOrder, true, true, 0, PROBE_DBG>(ring, g, S, EN, P.wave); }
        else if (lo == 228) { pg8::Gemm g{XB, wt(P, lp, WO_W13), 1024, 1024, 256 + kz_}; pg8::StaticOrder S; S.init(TT, 2048, P.G, (int)blockIdx.x, 1024, 1024); pg8::gemm_phase<pg8::EpiNull, pg8::StaticOrder, true, true, 0, PROBE_DBG>(ring, g, S, EN, P.wave); }
        else if (lo == 229) { pg8::Gemm g{XB, wt(P, lp, WO_W13), 320, 320, 256 + kz_}; pg8::StaticOrder S; S.init(TT, 2048, P.G, (int)blockIdx.x, 320, 320); pg8::gemm_phase<pg8::EpiNull, pg8::StaticOrder, true, true, 0, PROBE_DBG>(ring, g, S, EN, P.wave); }
        else if (lo == 232) { pg8::Gemm g{(bf16*)fact(P, FA_XC), wt(P, lp, WO_WG), 1024, 192, 128 + kz_}; pg8::GateOrder S{P.G, (int)blockIdx.x}; pg8::gemm_phase<pg8::EpiNull, pg8::GateOrder, true, true, 0, PROBE_DBG>(ring, g, S, EN, P.wave); }
        else if (lo == 233) { pg8::Gemm g{(bf16*)fact(P, FA_CQ), wt(P, lp, WO_WQB), 448, 448, 384 + kz_}; pg8::StaticOrder S; S.init(TT, 1536, P.G, (int)blockIdx.x, 448, 448); pg8::gemm_phase<pg8::EpiNull, pg8::StaticOrder, true, true, 0, PROBE_DBG>(ring, g, S, EN, P.wave); }
        else if (lo == 225) { pg8::Gemm g{XB, wt(P, lp, WO_LIN), 1024, 1024, 1024 + kz_}; pg8::StaticOrder S; S.init(TT, 2048, P.G, (int)blockIdx.x, 1024, 1024); pg8::gemm_phase<pg8::EpiNull, pg8::StaticOrder, true, true, 0, PROBE_DBG>(ring, g, S, EN, P.wave); }
        else if (lo == 226) { pg8::Gemm g{(bf16*)fact(P, FA_XC), wt(P, lp, WO_WG), 1024, WG_LD, 128 + kz_}; pg8::GateOrder S{P.G, (int)blockIdx.x}; pg8::gemm_phase<pg8::EpiNull, pg8::GateOrder, true, true, 0, PROBE_DBG>(ring, g, S, EN, P.wave); }
        else { pg8::Gemm g{XB, wt(P, lp, WO_WINA), 1024, 1024, 1024 + kz_}; pg8::StaticOrder S; S.init(TT, 768, P.G, (int)blockIdx.x, 1024, 1024); pg8::gemm_phase<pg8::EpiNull, pg8::StaticOrder, true, true, 0, PROBE_DBG>(ring, g, S, EN, P.wave); }
        return; }
#endif
#ifdef PROBE_EXTRA
    if (lo == 244 || lo == 245) { OPAQUE_FRAME(P); bf16* XB = (bf16*)fact(P, FA_XB);
        pg8::Gemm g{XB, wt(P, 0, WO_W13), 1024, 1024, 1024}; pg8::StaticOrder S; S.init(TT, 5632, P.G, (int)blockIdx.x, 1024, 1024);
        pg8::EpiSwiGLU E{(bf16*)fact(P, FA_H), 2816, lo == 244 ? ssq_arr(P, 1) : nullptr, 22, 0, 1.f};
        pg8::gemm_phase<pg8::EpiSwiGLU, pg8::StaticOrder, true, true>(ring, g, S, E, P.wave); return; }
#endif
#ifdef PROBE_EXTRA
    if (lo == 243) { if (blockIdx.x == 0 && F.tid < 8) F.ctl[CW_MOE + 64 + 16 + F.tid] = 0u; return; }
    if (lo == 299) return;
#endif
    if (lo == 200) { OPAQUE_FRAME(P); p0_prologue(P, 0, 2 * JOBS_PER_PAIR, false); return; }
    if (lo >= PH_PREP) { OPAQUE_FRAME(P); prep_rows(P, P.X, nullptr, ssq_arr(P, lo - PH_PREP)); return; }

    for (int lp = 0; lp < 2; ++lp) {
        const int pb = 1 + lp * PH_PER_PAIR;
        if (IN(pb + PH_M1)) { OPAQUE_FRAME(P); bf16* XB = (bf16*)fact(P, FA_XB);
            pg8::Gemm g{XB, wt(P, lp, WO_WINA), 1024, 1024, 1024}; pg8::StaticOrder S; S.init(TT, 768, P.G, (int)blockIdx.x, 1024, 1024);
            pg8::EpiMlaIn E{(bf16*)fact(P, FA_CQ), (bf16*)fact(P, FA_CKV), (float*)fact(P, FA_KR), ssq_arr(P, 4 * lp), ssq_arr(P, 8 + 3 * lp), ssq_arr(P, 9 + 3 * lp), ssq_arr(P, 10 + 3 * lp), PIN(10) + lp * 192, (const float*)fact(P, FA_ROPE)};
            pg8::gemm_phase<pg8::EpiMlaIn, pg8::StaticOrder, true, true>(ring, g, S, E, P.wave);
            if (TAIL_SLOTS && LATE_SLOTS) { const int fi = S.nwg < P.G ? S.nwg : P.G; if (lp == 1) tail_convert(P, 55, 56, fi); else tail_convert(P, 23, 24, fi); }
            SEAM(pb + PH_M1);
        }
        if (IN(pb + PH_M2)) {
            { OPAQUE_FRAME(P);
              int kz_; asm volatile("v_mov_b32 %0, 0" : "=v"(kz_)); kz_ = __builtin_amdgcn_readfirstlane(kz_);
              pg8::Gemm g{(bf16*)fact(P, FA_CKV), wt(P, lp, WO_WKVB), CKV_LD, CKV_LD, 256 + kz_}; pg8::StaticOrder S; S.init(TT, 2048, P.G, (int)blockIdx.x, CKV_LD, CKV_LD);
              pg8::EpiKV E{fact(P, FA_K), fact(P, FA_V), (const float*)fact(P, FA_KR), ssq_arr(P, 9 + 3 * lp), ssq_arr(P, 10 + 3 * lp), PIN(10) + lp * 192, (LAS float*)(P.lds + XCH_OFF)};
              pg8::gemm_phase<pg8::EpiKV, pg8::StaticOrder, true, true>(ring, g, S, E, P.wave); }
            { OPAQUE_FRAME(P);
              int kz_; asm volatile("v_mov_b32 %0, 0" : "=v"(kz_)); kz_ = __builtin_amdgcn_readfirstlane(kz_);
              pg8::Gemm g{(bf16*)fact(P, FA_CQ), wt(P, lp, WO_WQB), CQ_LD, CQ_LD, 384 + kz_}; pg8::StaticOrder S; S.init(TT, 1536, P.G, (int)blockIdx.x, CQ_LD, CQ_LD);
              pg8::EpiRstdBf16 E{(bf16*)fact(P, FA_Q), 1536, ssq_arr(P, 8 + 3 * lp), 1.f / 384.f};
              pg8::gemm_phase<pg8::EpiRstdBf16, pg8::StaticOrder, true, true>(ring, g, S, E, P.wave);
              if (TAIL_SLOTS && LATE_SLOTS) { const int fi = S.nwg % P.G; if (lp == 1) tail_convert(P, 62, 63, fi ? fi : P.G); else tail_convert(P, 31, 32, fi ? fi : P.G); } }
            SEAM(pb + PH_M2);
        }
        if (IN(pb + PH_ATT)) { OPAQUE_FRAME(P); att::attn_phase(P, lp); SEAM(pb + PH_ATT); }
        if (IN(pb + PH_WO)) { OPAQUE_FRAME(P); bf16* XB = (bf16*)fact(P, FA_XB);
            pg8::Gemm g{(bf16*)fact(P, FA_O), wt(P, lp, WO_WO), 1024, 1024, 1024}; pg8::StaticOrder S; S.init(TT, 1024, P.G, (int)blockIdx.x, 1024, 1024);
#if FFN_F8
            pg8::EpiResid E{P.X, ffn_fu8(lp) ? nullptr : XB, ssq_arr(P, 4 * lp + 1), nullptr, ffn_fu8(lp) ? fact(P, FA_XB8) : nullptr, 1.f};
#else
            pg8::EpiResid E{P.X, XB, ssq_arr(P, 4 * lp + 1), nullptr};
#endif
            pg8::gemm_phase<pg8::EpiResid, pg8::StaticOrder, true, true>(ring, g, S, E, P.wave);
            SEAM(pb + PH_WO);
        }
        if (IN(pb + PH_FU)) { OPAQUE_FRAME(P); bf16* XB = (bf16*)fact(P, FA_XB); pg8::StaticOrder S;
#if FFN_F8
            if (ffn_fu8(lp)) {
            int kz_; asm volatile("v_mov_b32 %0, 0" : "=v"(kz_)); kz_ = __builtin_amdgcn_readfirstlane(kz_);
            pg8::Gemm g{(bf16*)fact(P, FA_XB8), wt(P, lp, WO_W13), 512, 512, 512 + kz_, 127, 127}; S.init(TT, 5632, P.G, (int)blockIdx.x, 512, 512);
            pg8::EpiSwiGLU E{(bf16*)fact(P, FA_H), 2816, ssq_arr(P, 4 * lp + 1), 22, ffn_fd8(lp) ? 1 : 0, 1.f / 64.f};
            pg8::gemm_phase<pg8::EpiSwiGLU, pg8::StaticOrder, true, true, 1>(ring, g, S, E, P.wave);
            } else
#endif
            {
            pg8::Gemm g{XB, wt(P, lp, WO_W13), 1024, 1024, 1024}; S.init(TT, 5632, P.G, (int)blockIdx.x, 1024, 1024);
            pg8::EpiSwiGLU E{(bf16*)fact(P, FA_H), 2816, ssq_arr(P, 4 * lp + 1), 22, ffn_fd8(lp) ? 1 : 0, 1.f};
            pg8::gemm_phase<pg8::EpiSwiGLU, pg8::StaticOrder, true, true>(ring, g, S, E, P.wave);
            }
            if (TAIL_SLOTS) { const int fi = S.nwg % P.G; if (lp == 0) tail_convert(P, 56, 59, fi ? fi : P.G); else if (LATE_SLOTS) tail_convert(P, 63, 64, fi ? fi : P.G); }
            SEAM(pb + PH_FU);
        }
        if (IN(pb + PH_FD)) { OPAQUE_FRAME(P); bf16* XB = (bf16*)fact(P, FA_XB);
#if FFN_F8
            if (ffn_fd8(lp)) {
            int kz_; asm volatile("v_mov_b32 %0, 0" : "=v"(kz_)); kz_ = __builtin_amdgcn_readfirstlane(kz_);
            pg8::Gemm g{(bf16*)fact(P, FA_H), wt(P, lp, WO_W2), 1408, 1408, 1408 + kz_, 127, 127}; pg8::StaticOrder S; S.init(TT, 1024, P.G, (int)blockIdx.x, 1408, 1408);
            pg8::EpiResid E{P.X, lru_in8(lp) ? nullptr : XB, ssq_arr(P, 4 * lp + 2), nullptr, lru_in8(lp) ? fact(P, FA_XB8) : nullptr, 1.f / 64.f};
            pg8::gemm_phase<pg8::EpiResid, pg8::StaticOrder, true, true, 1>(ring, g, S, E, P.wave);
            } else {
            pg8::Gemm g{(bf16*)fact(P, FA_H), wt(P, lp, WO_W2), 2816, 2816, 2816}; pg8::StaticOrder S; S.init(TT, 1024, P.G, (int)blockIdx.x, 2816, 2816);
            pg8::EpiResid E{P.X, lru_in8(lp) ? nullptr : XB, ssq_arr(P, 4 * lp + 2), nullptr, lru_in8(lp) ? fact(P, FA_XB8) : nullptr, 1.f};
            pg8::gemm_phase<pg8::EpiResid, pg8::StaticOrder, true, true>(ring, g, S, E, P.wave);
            }
#else
            pg8::Gemm g{(bf16*)fact(P, FA_H), wt(P, lp, WO_W2), 2816, 2816, 2816}; pg8::StaticOrder S; S.init(TT, 1024, P.G, (int)blockIdx.x, 2816, 2816);
            pg8::EpiResid E{P.X, XB, ssq_arr(P, 4 * lp + 2), nullptr};
            pg8::gemm_phase<pg8::EpiResid, pg8::StaticOrder, true, true>(ring, g, S, E, P.wave);
#endif
            SEAM(pb + PH_FD);
        }
        if (IN(pb + PH_L1)) { OPAQUE_FRAME(P); bf16* XB = (bf16*)fact(P, FA_XB);
#if LRU_F8
            if (lru_in8(lp)) {
            int kz_; asm volatile("v_mov_b32 %0, 0" : "=v"(kz_)); kz_ = __builtin_amdgcn_readfirstlane(kz_);
            pg8::Gemm g{(bf16*)fact(P, FA_XB8), wt(P, lp, WO_LIN), 512, 512, 512 + kz_, 127, 127}; pg8::StaticOrder S; S.init(TT, 2048, P.G, (int)blockIdx.x, 512, 512);
            pg8::EpiLruIn E{(bf16*)fact(P, FA_G), (bf16*)fact(P, FA_XBR), ssq_arr(P, 4 * lp + 2), PIN(13) + lp * 2048, 1.f / 64.f};
            pg8::gemm_phase<pg8::EpiLruIn, pg8::StaticOrder, true, true, 1>(ring, g, S, E, P.wave);
            } else
#endif
            {
            pg8::Gemm g{XB, wt(P, lp, WO_LIN), 1024, 1024, 1024}; pg8::StaticOrder S; S.init(TT, 2048, P.G, (int)blockIdx.x, 1024, 1024);
            pg8::EpiLruIn E{(bf16*)fact(P, FA_G), (bf16*)fact(P, FA_XBR), ssq_arr(P, 4 * lp + 2), PIN(13) + lp * 2048, 1.f};
            pg8::gemm_phase<pg8::EpiLruIn, pg8::StaticOrder, true, true>(ring, g, S, E, P.wave);
            }
            SEAM(pb + PH_L1);
        }
#ifndef FUSE_L23
#define FUSE_L23 1
#endif
        if (IN(pb + PH_L2) && !(FUSE_L23 && multi)) { OPAQUE_FRAME(P); conv_phase(P, lp); SEAM(pb + PH_L2); }
        if (IN(pb + PH_L3)) { OPAQUE_FRAME(P); bf16* XB = (bf16*)fact(P, FA_XB);
            if (FUSE_L23 && multi) conv_for_gates(P, lp);
            int kz_; asm volatile("v_mov_b32 %0, 0" : "=v"(kz_)); kz_ = __builtin_amdgcn_readfirstlane(kz_);
            pg8::Gemm g{(bf16*)fact(P, FA_XC), wt(P, lp, WO_WG), 1024, WG_LD, 128 + kz_}; pg8::GateOrder S{P.G, (int)blockIdx.x};
            pg8::EpiGates E{(bf16*)fact(P, FA_LA), (bf16*)fact(P, FA_U), PIN(17) + lp * 1024, PIN(19) + lp * 1024};
            pg8::gemm_phase<pg8::EpiGates, pg8::GateOrder, true, true>(ring, g, S, E, P.wave);
            SEAM(pb + PH_L3);
        }
        if (IN(pb + PH_L4)) { OPAQUE_FRAME(P); scan_phase(P, lp); SEAM(pb + PH_L4); }
        if (IN(pb + PH_L5)) { OPAQUE_FRAME(P); bf16* XB = (bf16*)fact(P, FA_XB);
#if FFN_F8
            if (lru_out8(lp)) {
            int kz_; asm volatile("v_mov_b32 %0, 0" : "=v"(kz_)); kz_ = __builtin_amdgcn_readfirstlane(kz_);
            pg8::Gemm g{(bf16*)fact(P, FA_YG), wt(P, lp, WO_WOUT), 512, 512, 512 + kz_, 127, 127}; pg8::StaticOrder S; S.init(TT, 1024, P.G, (int)blockIdx.x, 512, 512);
            pg8::EpiResid E{P.X, XB, nullptr, PIN(22) + lp * 1024, nullptr, 1.f / 64.f};
            pg8::gemm_phase<pg8::EpiResid, pg8::StaticOrder, true, true, 1>(ring, g, S, E, P.wave);
            } else
#endif
            {
            pg8::Gemm g{(bf16*)fact(P, FA_YG), wt(P, lp, WO_WOUT), 1024, 1024, 1024}; pg8::StaticOrder S; S.init(TT, 1024, P.G, (int)blockIdx.x, 1024, 1024);
#if FFN_F8
            pg8::EpiResid E{P.X, XB, nullptr, PIN(22) + lp * 1024, nullptr, 1.f};
#else
            pg8::EpiResid E{P.X, XB, nullptr, PIN(22) + lp * 1024};
#endif
            pg8::gemm_phase<pg8::EpiResid, pg8::StaticOrder, true, true>(ring, g, S, E, P.wave);
            }
            SEAM(pb + PH_L5);
        }
        if (IN(pb + PH_R1)) { OPAQUE_FRAME(P); r1_phase(P, lp); SEAM(pb + PH_R1); }
        if (IN(pb + PH_R2)) { OPAQUE_FRAME(P); r2_phase(P, lp); SEAM(pb + PH_R2); }
        if (IN(pb + PH_MU) && lp != FP8_LP) { OPAQUE_FRAME(P);
            const MoeSeg sg = moe_segments(P, lp);
#if FP8_ALL
            int kz_; asm volatile("v_mov_b32 %0, 0" : "=v"(kz_)); kz_ = __builtin_amdgcn_readfirstlane(kz_);
            pg8::Gemm g{(bf16*)fact(P, FA_AS), wt(P, lp, WO_M13), MOE8_PITCH / 2, MOE8_PITCH / 2, 512 + kz_, 127, 127}; pg8::MoeOrder S; S.init(sg, 28, P.G, (int)blockIdx.x, MOE8_PITCH / 2, MOE8_PITCH / 2);
            pg8::EpiSwiGLU E{(bf16*)fact(P, FA_MH), 3584, nullptr, 28, 1, 1.f / 64.f};
            pg8::gemm_phase<pg8::EpiSwiGLU, pg8::MoeOrder, true, true, 1>(ring, g, S, E, P.wave);
            if (TAIL_SLOTS) { const int nl = S.U % P.G; if (lp == 0) tail_convert(P, 54, 55, nl ? nl : P.G); else if (LATE_SLOTS) tail_convert(P, 59, 61, nl ? nl : P.G); }
#else
            pg8::Gemm g{(bf16*)fact(P, FA_AS), wt(P, lp, WO_M13), 1024, 1024, 1024}; pg8::MoeOrder S; S.init(sg, 28, P.G, (int)blockIdx.x, 1024, 1024);
            pg8::EpiSwiGLU E{(bf16*)fact(P, FA_MH), 3584, (const fx64*)fact(P, FA_SLOT + SL_SSQ), 28, 0, 1.f};
            pg8::gemm_phase<pg8::EpiSwiGLU, pg8::MoeOrder, true, true>(ring, g, S, E, P.wave);
#endif
            SEAM(pb + PH_MU);
        }
        if (IN(pb + PH_MD) && lp != FP8_LP) { OPAQUE_FRAME(P);
            const MoeSeg sg = moe_segments(P, lp);
#if FP8_ALL
            int kz_; asm volatile("v_mov_b32 %0, 0" : "=v"(kz_)); kz_ = __builtin_amdgcn_readfirstlane(kz_);
            pg8::EpiScaleBf16 E{(bf16*)fact(P, FA_Y), 1024, nullptr, 4, 1.f / 128.f};
            MoeSeg s1 = sg;
            if (moe_ksplit(lp)) {
#pragma unroll
                for (int e = 0; e < 8; ++e) { const int room = 128 - sg.ps[e]; s1.np[e] = room <= 0 ? 0 : (sg.np[e] < room ? sg.np[e] : room); }
                s1.total = sg.total < 128 ? sg.total : 128; }
            pg8::Gemm g{(bf16*)fact(P, FA_MH), wt(P, lp, WO_M2), 1792, 1792, 1792 + kz_, 127, 127}; pg8::MoeOrder S; S.init(s1, 4, P.G, (int)blockIdx.x, 1792, 1792);
            pg8::gemm_phase<pg8::EpiScaleBf16, pg8::MoeOrder, true, true, 1>(ring, g, S, E, P.wave);
            if (moe_ksplit(lp)) {
                pg8::EpiScaleBf16 E2{(bf16*)fact(P, FA_AS), 1024, nullptr, 4, 1.f / 128.f};
                pg8::Gemm g2{(bf16*)fact(P, FA_MH), wt(P, lp, WO_M2), 1792, 1792, 256 + kz_, 127, 127}; pg8::SplitOrder S2; S2.init(sg, P.G, (int)blockIdx.x, 1792, 1792);
                pg8::gemm_phase<pg8::EpiScaleBf16, pg8::SplitOrder, true, true, 1>(ring, g2, S2, E2, P.wave); }
            if (TAIL_SLOTS && lp == 0) tail_convert(P, 48, 54, S.U > 2 * P.G ? S.U - 2 * P.G : P.G);
#else
            pg8::EpiScaleBf16 E{(bf16*)fact(P, FA_Y), 1024, nullptr, 4, 1.f};
            pg8::Gemm g{(bf16*)fact(P, FA_MH), wt(P, lp, WO_M2), 3584, 3584, 3584}; pg8::MoeOrder S; S.init(sg, 4, P.G, (int)blockIdx.x, 3584, 3584);
            pg8::gemm_phase<pg8::EpiScaleBf16, pg8::MoeOrder, true, true>(ring, g, S, E, P.wave);
#endif
            SEAM(pb + PH_MD);
        }
        if (IN(pb + PH_CB) && lp != FP8_LP) { OPAQUE_FRAME(P); cb_phase(P, lp); SEAM(pb + PH_CB); }
    }
    if (FP8_LP >= 0) { const int lp = FP8_LP, pb = 1 + lp * PH_PER_PAIR;
        if (IN(pb + PH_MU)) { OPAQUE_FRAME(P);
            const MoeSeg sg = moe_segments(P, lp);
            int kz_; asm volatile("v_mov_b32 %0, 0" : "=v"(kz_)); kz_ = __builtin_amdgcn_readfirstlane(kz_);
            pg8::Gemm g{(bf16*)fact(P, FA_AS), wt(P, lp, WO_M13), MOE8_PITCH / 2, MOE8_PITCH / 2, 512 + kz_, 127, 127 - 6}; pg8::MoeOrder S; S.init(sg, 28, P.G, (int)blockIdx.x, MOE8_PITCH / 2, MOE8_PITCH / 2);
            pg8::EpiSwiGLU E{(bf16*)fact(P, FA_MH), 3584, (const fx64*)fact(P, FA_SLOT + SL_SSQ), 28, 1, 1.f / 64.f};
            pg8::gemm_phase<pg8::EpiSwiGLU, pg8::MoeOrder, true, true, 1>(ring, g, S, E, P.wave);
            SEAM(pb + PH_MU);
        }
        if (IN(pb + PH_MD)) { OPAQUE_FRAME(P);
            const MoeSeg sg = moe_segments(P, lp);
            int kz_; asm volatile("v_mov_b32 %0, 0" : "=v"(kz_)); kz_ = __builtin_amdgcn_readfirstlane(kz_);
            pg8::EpiScaleBf16 E{(bf16*)fact(P, FA_Y), 1024, nullptr, 4, 1.f / 128.f};
            pg8::Gemm g{(bf16*)fact(P, FA_MH), wt(P, lp, WO_M2), 1792, 1792, 1792 + kz_, 127, 127 - 7}; pg8::MoeOrder S; S.init(sg, 4, P.G, (int)blockIdx.x, 1792, 1792);
            pg8::gemm_phase<pg8::EpiScaleBf16, pg8::MoeOrder, true, true, 1>(ring, g, S, E, P.wave);
            SEAM(pb + PH_MD);
        }
        if (IN(pb + PH_CB)) { OPAQUE_FRAME(P); cb_phase(P, lp); SEAM(pb + PH_CB); }
    }
#undef IN
#undef SEAM
}

static void launch_mega(hipStream_t stream, const Args& a0, int grid, int lo, int hi) {
    Args a = a0; a.ph_lo = lo; a.ph_hi = hi;
    hipLaunchKernelGGL(mega, dim3(grid), dim3(NWAVES * 64), LDS_BYTES, stream, a);
}
#if ONE_LAUNCH
extern "C" void kernel_launch(void* const* d_in, const int* in_sizes, int n_in, void* d_out, int out_size, void* d_ws, size_t ws_size, hipStream_t stream) {
    if (n_in != 31 || out_size != TT * 1024 || ws_size < 896 * MiB) { fprintf(stderr, "kernel_launch: bad shapes n_in %d out %d ws %zu\n", n_in, out_size, ws_size); return; }
    static int grid = 0;
    if (!grid) {
        if (hipFuncSetAttribute((const void*)mega, hipFuncAttributeMaxDynamicSharedMemorySize, LDS_BYTES) != hipSuccess) { fprintf(stderr, "kernel_launch: hipFuncSetAttribute failed\n"); grid = -1; return; }
        int dev = 0, cus = 0, per_cu = 0; (void)hipGetDevice(&dev); (void)hipDeviceGetAttribute(&cus, hipDeviceAttributeMultiprocessorCount, dev);
        if (hipOccupancyMaxActiveBlocksPerMultiprocessor(&per_cu, (const void*)mega, NWAVES * 64, LDS_BYTES) != hipSuccess || per_cu < 1) fprintf(stderr, "kernel_launch: occupancy query reports %d blocks per CU\n", per_cu);
        (void)hipGetLastError();
        grid = cus > 0 ? cus : 256;
    }
    if (grid < 0) return;
    unsigned char* ws = (unsigned char*)d_ws;
    (void)hipMemsetAsync(ws + WS_CTL, 0, CTL_ZERO_BYTES, stream);
    Args a; memset(&a, 0, sizeof(a)); for (int i = 0; i < 31; ++i) a.in[i] = (const float*)d_in[i]; a.out = (float*)d_out; a.ws = ws;
    launch_mega(stream, a, grid, 0, PH_END);
#ifdef PROBE_EXTRA
    { const int extra[] = {PROBE_EXTRA}; for (int e : extra) launch_mega(stream, a, grid, e, e + 1); }
#endif
}
#else
extern "C" void kernel_launch(void* const* d_in, const int* in_sizes, int n_in, void* d_out, int out_size, void* d_ws, size_t ws_size, hipStream_t stream) {
    if (n_in != 31 || out_size != orc::T * 1024 || ws_size < 896 * MiB) { fprintf(stderr, "kernel_launch: bad shapes n_in %d out %d ws %zu\n", n_in, out_size, ws_size); return; }
    static int grid = 0;
    if (!grid) {
        hipFuncSetAttribute((const void*)orc::attn, hipFuncAttributeMaxDynamicSharedMemorySize, orc::ATT_LDS);
        hipFuncSetAttribute((const void*)mega, hipFuncAttributeMaxDynamicSharedMemorySize, LDS_BYTES);
        int dev = 0, cus = 0; hipGetDevice(&dev); hipDeviceGetAttribute(&cus, hipDeviceAttributeMultiprocessorCount, dev); grid = cus > 0 ? cus : 256;
    }
    const float* const* in = (const float* const*)d_in; const int* pos = (const int*)d_in[1];
    unsigned char* ws = (unsigned char*)d_ws; float* X = (float*)d_out;
    orc::Bufs b; unsigned char* act = ws + WS_FACT;
    b.XN = (float*)act; b.HC = (float*)(act + 64 * MiB); b.Kf = (float*)(act + 112 * MiB); b.Q = (float*)(act + 208 * MiB); b.KV = (float*)(act + 304 * MiB); b.H = (float*)(act + 208 * MiB);
    unsigned char* sm = ws + 5 * MiB; b.te = (int*)sm; b.tw = (float*)(sm + 128 * 1024); b.list = (int*)(sm + 256 * 1024); b.gate = (float*)(sm + 768 * 1024); b.cnt = (int*)(sm + 1280 * 1024);
    hipMemsetAsync(ws + WS_CTL, 0, CTL_ZERO_BYTES, stream);
    Args a; memset(&a, 0, sizeof(a)); for (int i = 0; i < 31; ++i) a.in[i] = (const float*)d_in[i]; a.out = X; a.ws = ws;
    launch_mega(stream, a, grid, 0, 1);
    for (int i = 0; i < 4; ++i) {
        const int j = i / 2, pb = 1 + j * PH_PER_PAIR;
        if (i % 2 == 0) {
#if FAST_MLA
            launch_mega(stream, a, grid, PH_PREP + 4 * j, PH_PREP + 4 * j + 1);
            for (int p = PH_M1; p <= PH_WO; ++p) launch_mega(stream, a, grid, pb + p, pb + p + 1);
#else
            orc::mla(stream, X, b, pos, in[2] + i * 1024, in[4] + (size_t)j * 1024 * 704, in[5] + j * 384, in[6] + (size_t)j * 384 * 1536, in[7] + j * 256, in[8] + (size_t)j * 256 * 2048, in[9] + j * 192, in[10] + j * 192, in[11] + (size_t)j * 1024 * 1024);
#endif
#if FAST_FFN
#if !FAST_MLA
            launch_mega(stream, a, grid, PH_PREP + 4 * j + 1, PH_PREP + 4 * j + 2);
#endif
            launch_mega(stream, a, grid, pb + PH_FU, pb + PH_FU + 1);
            launch_mega(stream, a, grid, pb + PH_FD, pb + PH_FD + 1);
#else
            orc::ffn(stream, X, b, in[3] + i * 1024, in[23] + (size_t)j * 1024 * 2816, in[24] + (size_t)j * 1024 * 2816, in[25] + (size_t)j * 2816 * 1024);
#endif
        } else {
#if FAST_LRU
            launch_mega(stream, a, grid, PH_PREP + 4 * j + 2, PH_PREP + 4 * j + 3);
            for (int p = PH_L1; p <= PH_L5; ++p) launch_mega(stream, a, grid, pb + p, pb + p + 1);
#else
            orc::lru(stream, X, b, in[2] + i * 1024, in[12] + (size_t)j * 1024 * 2048, in[13] + j * 2048, in[14] + j * 4096, in[15] + j * 1024, in[16] + (size_t)j * 8 * 128 * 128, in[17] + j * 1024,
                     in[18] + (size_t)j * 8 * 128 * 128, in[19] + j * 1024, in[20] + j * 1024, in[21] + (size_t)j * 1024 * 1024, in[22] + j * 1024);
#endif
#if FAST_MOE
            launch_mega(stream, a, grid, PH_PREP + 4 * j + 3, PH_PREP + 4 * j + 4);
            for (int p = PH_R1; p <= PH_CB; ++p) launch_mega(stream, a, grid, pb + p, pb + p + 1);
#else
            orc::moe(stream, X, b, in[3] + i * 1024, in[26] + j * 1024 * 8, in[27] + j * 8, in[28] + (size_t)j * 8 * 1024 * 3584, in[29] + (size_t)j * 8 * 1024 * 3584, in[30] + (size_t)j * 8 * 3584 * 1024);
#endif
        }
    }
}
#endif
```
